# Optimizing an MI355X kernel written in HIP

```python
import jax, jax.numpy as jnp
from jax import lax
import numpy as np

D_MODEL = 1024
BATCH = 2
SEQ = 8192
DEPTH = 2
DEC_BATCH = 128
DEC_SEQ = 4
PAST_LEN = 8192
PAGE_SIZE = 128

ALPHA = (2 * DEPTH) ** 0.25
BETA = (8 * DEPTH) ** -0.25
N_EVEN = (DEPTH + 1) // 2
N_ODD = DEPTH // 2
D_FF = 2816
MLA_HEADS = 8
Q_LORA = 512
KV_LORA = 256
QK_NOPE = 64
QK_ROPE = 32
V_DIM = 64
Q_BLOCK = 128
RET_HEADS = 4
RET_DK = 128
RET_DV = 128
RET_CHUNK = 128
POOL_WINDOWS = (2, 4, 8, 16)
POOL_GROUPS = 4
POOL_GROUP = D_MODEL // POOL_GROUPS
POOL_PREFIX = 15
ROPE_BASE = 10000.0
LN_EPS = 1e-5
RMS_EPS = 1e-6
D_MIX = MLA_HEADS * V_DIM + RET_HEADS * RET_DV
SPLIT_SIZES = (Q_LORA, KV_LORA, QK_ROPE, RET_HEADS * RET_DK, RET_HEADS * RET_DK, RET_HEADS * RET_DV, RET_HEADS * RET_DV)
D_IN = Q_LORA + KV_LORA + QK_ROPE + 2 * RET_HEADS * RET_DK + 2 * RET_HEADS * RET_DV

kernel_name = 'hybrid_mla_retention_pool_decoder'


def layer_norm(x, g, b):
    xf = x.astype(jnp.float32)
    mu = xf.mean(-1, keepdims=True)
    var = jnp.square(xf - mu).mean(-1, keepdims=True)
    return ((xf - mu) * lax.rsqrt(var + LN_EPS) * g + b).astype(x.dtype)


def rms_norm(x, g):
    xf = x.astype(jnp.float32)
    return (xf * lax.rsqrt(jnp.square(xf).mean(-1, keepdims=True) + RMS_EPS) * g).astype(x.dtype)


def rope(x, pos):
    r = x.shape[-1]
    inv = 1.0 / (ROPE_BASE ** (jnp.arange(0, r, 2, dtype=jnp.float32) / r))
    ang = pos.astype(jnp.float32)[:, None] * inv[None, :]
    ang = ang.reshape(ang.shape[:1] + (1,) * (x.ndim - 3) + ang.shape[1:])
    cos, sin = jnp.cos(ang), jnp.sin(ang)
    xf = x.astype(jnp.float32)
    x1, x2 = xf[..., : r // 2], xf[..., r // 2:]
    return jnp.concatenate([x1 * cos - x2 * sin, x1 * sin + x2 * cos], -1).astype(x.dtype)


def swiglu(x, wg, wu, wd):
    return (jax.nn.silu(x @ wg) * (x @ wu)) @ wd


def half_ffn_block(h, w, layer, m):
    f = swiglu(h, w['ffn_w_gate'][layer, m], w['ffn_w_up'][layer, m], w['ffn_w_down'][layer, m])
    return layer_norm(ALPHA * h + 0.5 * f, w['ln_gain'][layer, 2 * m], w['ln_bias'][layer, 2 * m])


def mla_prompt_attend(q_nope, q_pe, ckv, kpe, w_uk, w_uv):
    B, T, H, _ = q_nope.shape
    k_nope = jnp.einsum('btc,chd->bthd', ckv, w_uk)
    v = jnp.einsum('btc,chd->bthd', ckv, w_uv)
    nb = T // Q_BLOCK
    kpos = jnp.arange(T)
    scale = (QK_NOPE + QK_ROPE) ** -0.5
    neg = jnp.finfo(jnp.float32).min

    def blocks(a):
        return a.reshape((B, nb, Q_BLOCK) + a.shape[2:]).swapaxes(0, 1)

    def one_block(args):
        i, qn, qp = args
        s = jnp.einsum('bqhd,bkhd->bhqk', qn, k_nope) + jnp.einsum('bqhr,bkr->bhqk', qp, kpe)
        s = s.astype(jnp.float32) * scale
        qpos = i * Q_BLOCK + jnp.arange(Q_BLOCK)
        s = jnp.where(kpos[None, :] <= qpos[:, None], s, neg)
        p = jax.nn.softmax(s, axis=-1).astype(v.dtype)
        return jnp.einsum('bhqk,bkhd->bqhd', p, v)

    o = lax.map(one_block, (jnp.arange(nb), blocks(q_nope), blocks(q_pe)))
    return o.swapaxes(0, 1).reshape(B, T, H, V_DIM)


def mla_paged_attend(q_nope, q_pe, ckv_new, kpe_new, ckv_past, kpe_past, w_uk, w_uv):
    B, T, H, _ = q_nope.shape
    P = ckv_past.shape[1]
    scale = (QK_NOPE + QK_ROPE) ** -0.5
    neg = jnp.finfo(jnp.float32).min
    q_lat = jnp.einsum('bthd,chd->bthc', q_nope, w_uk)
    s_past = jnp.einsum('bthc,bkc->bhtk', q_lat, ckv_past) + jnp.einsum('bthr,bkr->bhtk', q_pe, kpe_past)
    s_new = jnp.einsum('bthc,bkc->bhtk', q_lat, ckv_new) + jnp.einsum('bthr,bkr->bhtk', q_pe, kpe_new)
    s = jnp.concatenate([s_past, s_new], -1).astype(jnp.float32) * scale
    causal = jnp.arange(T)[None, :] <= jnp.arange(T)[:, None]
    mask = jnp.concatenate([jnp.ones((T, P), dtype=bool), causal], -1)
    s = jnp.where(mask, s, neg)
    p = jax.nn.softmax(s, axis=-1).astype(ckv_past.dtype)
    o_lat = jnp.einsum('bhtk,bkc->bthc', p[..., :P], ckv_past) + jnp.einsum('bhtk,bkc->bthc', p[..., P:], ckv_new)
    return jnp.einsum('bthc,chd->bthd', o_lat, w_uv)


def retention(q, k, v, state0, chunk):
    B, T, H, DK = q.shape
    DV = v.shape[-1]
    n = T // chunk
    log_g = jnp.log(1.0 - 2.0 ** (-5.0 - jnp.arange(H, dtype=jnp.float32)))
    idx = jnp.arange(chunk, dtype=jnp.float32)
    diff = idx[:, None] - idx[None, :]
    d_in = jnp.where(diff >= 0, jnp.exp(jnp.maximum(diff, 0.0)[None] * log_g[:, None, None]), 0.0)
    q_dec = jnp.exp((idx + 1.0)[None, :] * log_g[:, None])[..., None]
    k_dec = jnp.exp((chunk - 1.0 - idx)[None, :] * log_g[:, None])[..., None]
    g_c = jnp.exp(chunk * log_g)[:, None, None]

    def to_chunks(a):
        return a.astype(jnp.float32).reshape(B, n, chunk, H, a.shape[-1]).transpose(1, 0, 3, 2, 4)

    def step(s, blk):
        qb, kb, vb = blk
        inner = jnp.einsum('bhid,bhjd->bhij', qb, kb) * d_in
        o = jnp.einsum('bhij,bhjv->bhiv', inner, vb) + jnp.einsum('bhid,bhdv->bhiv', qb * q_dec, s)
        s = s * g_c + jnp.einsum('bhjd,bhjv->bhdv', kb * k_dec, vb)
        return s, o

    s, o = lax.scan(step, state0.astype(jnp.float32), (to_chunks(q), to_chunks(k), to_chunks(v)))
    return o.transpose(1, 0, 3, 2, 4).reshape(B, T, H, DV), s


def mixer_ab(h, pos, ret_state0, mla_cache, w_in, q_norm, kv_norm, w_uq, w_uk, w_uv, gn_gain, gn_bias, w_out):
    B, T, _ = h.shape
    split_at = [int(i) for i in np.cumsum(SPLIT_SIZES)[:-1]]
    q_lat, ckv, kpe, rq, rk, rv, rg = jnp.split(h @ w_in, split_at, axis=-1)
    q = jnp.einsum('btc,chd->bthd', rms_norm(q_lat, q_norm), w_uq)
    q_nope, q_pe = q[..., :QK_NOPE], rope(q[..., QK_NOPE:], pos)
    ckv = rms_norm(ckv, kv_norm)
    kpe = rope(kpe, pos)
    if mla_cache is None:
        a = mla_prompt_attend(q_nope, q_pe, ckv, kpe, w_uk, w_uv)
    else:
        cache_ckv, cache_kpe, page_table = mla_cache
        ckv_past = cache_ckv[page_table].reshape(B, -1, KV_LORA)
        kpe_past = cache_kpe[page_table].reshape(B, -1, QK_ROPE)
        a = mla_paged_attend(q_nope, q_pe, ckv, kpe, ckv_past, kpe_past, w_uk, w_uv)
    rq = rope(rq.reshape(B, T, RET_HEADS, RET_DK), pos)
    rk = rope(rk.reshape(B, T, RET_HEADS, RET_DK), pos) * (RET_DK ** -0.5)
    rv = rv.reshape(B, T, RET_HEADS, RET_DV)
    chunk = RET_CHUNK if T % RET_CHUNK == 0 else T
    ro, ret_state = retention(rq, rk, rv, ret_state0, chunk)
    mu = ro.mean(-1, keepdims=True)
    var = jnp.square(ro - mu).mean(-1, keepdims=True)
    ro = ((ro - mu) * lax.rsqrt(var + LN_EPS)).reshape(B, T, RET_HEADS * RET_DV) * gn_gain + gn_bias
    ro = jax.nn.silu(rg.astype(jnp.float32)) * ro
    mixed = jnp.concatenate([a.reshape(B, T, MLA_HEADS * V_DIM), ro.astype(h.dtype)], -1)
    return mixed @ w_out, ckv, kpe, ret_state.astype(h.dtype)


def pool_mixer(h, prefix, pos, w, b, scale):
    B, T, D = h.shape
    xp = jnp.concatenate([prefix.astype(h.dtype), h], axis=1)
    c = jnp.cumsum(xp.astype(jnp.float32), axis=1)
    c = jnp.pad(c, ((0, 0), (1, 0), (0, 0)))
    end = c[:, POOL_PREFIX + 1:]
    outs = []
    for gi, wl in enumerate(POOL_WINDOWS):
        lo, hi = gi * POOL_GROUP, (gi + 1) * POOL_GROUP
        start = c[:, POOL_PREFIX + 1 - wl: POOL_PREFIX + 1 - wl + T, lo:hi]
        cnt = jnp.minimum(pos + 1, wl).astype(jnp.float32)[None, :, None]
        outs.append((end[..., lo:hi] - start) / cnt)
    pooled = jnp.concatenate(outs, -1) - h.astype(jnp.float32)
    y = jnp.einsum('btgi,gio->btgo', pooled.reshape(B, T, POOL_GROUPS, POOL_GROUP), w).reshape(B, T, D) + b
    return (scale * y).astype(h.dtype), xp[:, -POOL_PREFIX:]


def trunk(x, start, ret_states, pool_prefix, mla_cache, w):
    T = x.shape[1]
    pos = start + jnp.arange(T, dtype=jnp.int32)
    h = x
    ckvs, kpes, rets, pools = [], [], [], []
    for layer in range(DEPTH):
        j = layer // 2
        h = half_ffn_block(h, w, layer, 0)
        if layer % 2 == 0:
            cache_j = None if mla_cache is None else (mla_cache[0][j], mla_cache[1][j], mla_cache[2])
            y, ckv, kpe, rs = mixer_ab(h, pos, ret_states[j], cache_j, w['mix_w_in'][j], w['mla_q_norm'][j],
                                       w['mla_kv_norm'][j], w['mla_w_uq'][j], w['mla_w_uk'][j], w['mla_w_uv'][j],
                                       w['ret_gn_gain'][j], w['ret_gn_bias'][j], w['mix_w_out'][j])
            ckvs.append(ckv)
            kpes.append(kpe)
            rets.append(rs)
        else:
            y, rows = pool_mixer(h, pool_prefix[j], pos, w['pool_w'][j], w['pool_b'][j], w['pool_scale'][j])
            pools.append(rows)
        h = layer_norm(ALPHA * h + y, w['ln_gain'][layer, 1], w['ln_bias'][layer, 1])
        h = half_ffn_block(h, w, layer, 1)
    return h, jnp.stack(ckvs), jnp.stack(kpes), jnp.stack(rets), jnp.stack(pools)


def setup_inputs(seed: int = 0) -> dict:
    key = jax.random.key(seed)
    ks = jax.random.split(key, 24)
    n_pages = PAST_LEN // PAGE_SIZE
    n_used = DEC_BATCH * n_pages
    n_pool = n_used + max(1, n_used // 4)

    def nrm(k, shape, s=1.0):
        return s * jax.random.normal(k, shape, jnp.float32)

    page_table = jax.random.permutation(ks[6], n_pool)[:n_used].reshape(DEC_BATCH, n_pages).astype(jnp.int32)
    return {
        'x_prompt': nrm(ks[0], (BATCH, SEQ, D_MODEL)),
        'x_sample': nrm(ks[1], (DEC_BATCH, DEC_SEQ, D_MODEL)),
        'cache_mla_ckv': nrm(ks[2], (N_EVEN, n_pool, PAGE_SIZE, KV_LORA)),
        'cache_mla_kpe': nrm(ks[3], (N_EVEN, n_pool, PAGE_SIZE, QK_ROPE)),
        'state_ret': nrm(ks[4], (N_EVEN, DEC_BATCH, RET_HEADS, RET_DK, RET_DV), 0.5),
        'state_pool': nrm(ks[5], (N_ODD, DEC_BATCH, POOL_PREFIX, D_MODEL)),
        'page_table': page_table,
        'ffn_w_gate': nrm(ks[7], (DEPTH, 2, D_MODEL, D_FF), D_MODEL ** -0.5),
        'ffn_w_up': nrm(ks[8], (DEPTH, 2, D_MODEL, D_FF), D_MODEL ** -0.5),
        'ffn_w_down': nrm(ks[9], (DEPTH, 2, D_FF, D_MODEL), BETA * D_FF ** -0.5),
        'ln_gain': 1.0 + nrm(ks[10], (DEPTH, 3, D_MODEL), 0.05),
        'ln_bias': nrm(ks[11], (DEPTH, 3, D_MODEL), 0.02),
        'mix_w_in': nrm(ks[12], (N_EVEN, D_MODEL, D_IN), D_MODEL ** -0.5),
        'mla_q_norm': 1.0 + nrm(ks[13], (N_EVEN, Q_LORA), 0.05),
        'mla_kv_norm': 1.0 + nrm(ks[14], (N_EVEN, KV_LORA), 0.05),
        'mla_w_uq': nrm(ks[15], (N_EVEN, Q_LORA, MLA_HEADS, QK_NOPE + QK_ROPE), Q_LORA ** -0.5),
        'mla_w_uk': nrm(ks[16], (N_EVEN, KV_LORA, MLA_HEADS, QK_NOPE), KV_LORA ** -0.5),
        'mla_w_uv': nrm(ks[17], (N_EVEN, KV_LORA, MLA_HEADS, V_DIM), KV_LORA ** -0.5),
        'ret_gn_gain': 1.0 + nrm(ks[18], (N_EVEN, RET_HEADS * RET_DV), 0.05),
        'ret_gn_bias': nrm(ks[19], (N_EVEN, RET_HEADS * RET_DV), 0.02),
        'mix_w_out': nrm(ks[20], (N_EVEN, D_MIX, D_MODEL), BETA * D_MIX ** -0.5),
        'pool_w': nrm(ks[21], (N_ODD, POOL_GROUPS, POOL_GROUP, POOL_GROUP), BETA * POOL_GROUP ** -0.5),
        'pool_b': nrm(ks[22], (N_ODD, D_MODEL), 0.02),
        'pool_scale': 1.0 + nrm(ks[23], (N_ODD, D_MODEL), 0.1),
    }


def reference(x_prompt, x_sample, cache_mla_ckv, cache_mla_kpe, state_ret, state_pool, page_table,
              ffn_w_gate, ffn_w_up, ffn_w_down, ln_gain, ln_bias, mix_w_in, mla_q_norm, mla_kv_norm,
              mla_w_uq, mla_w_uk, mla_w_uv, ret_gn_gain, ret_gn_bias, mix_w_out, pool_w, pool_b, pool_scale):
    w = {'ffn_w_gate': ffn_w_gate, 'ffn_w_up': ffn_w_up, 'ffn_w_down': ffn_w_down,
         'ln_gain': ln_gain, 'ln_bias': ln_bias, 'mix_w_in': mix_w_in,
         'mla_q_norm': mla_q_norm, 'mla_kv_norm': mla_kv_norm, 'mla_w_uq': mla_w_uq,
         'mla_w_uk': mla_w_uk, 'mla_w_uv': mla_w_uv, 'ret_gn_gain': ret_gn_gain,
         'ret_gn_bias': ret_gn_bias, 'mix_w_out': mix_w_out, 'pool_w': pool_w,
         'pool_b': pool_b, 'pool_scale': pool_scale}
    bp = x_prompt.shape[0]
    zero_ret = jnp.zeros((N_EVEN, bp, RET_HEADS, RET_DK, RET_DV), jnp.float32)
    zero_pool = jnp.zeros((N_ODD, bp, POOL_PREFIX, D_MODEL), x_prompt.dtype)
    y_p, ckv_p, kpe_p, ret_p, pool_p = trunk(x_prompt, 0, zero_ret, zero_pool, None, w)
    y_s, ckv_s, kpe_s, ret_s, pool_s = trunk(x_sample, PAST_LEN, state_ret, state_pool,
                                             (cache_mla_ckv, cache_mla_kpe, page_table), w)
    return (y_p, y_s, ckv_p, kpe_p, ckv_s, kpe_s, ret_p, ret_s, pool_p, pool_s)
```

```cpp
#include <hip/hip_runtime.h>
#include <cstdio>
#include <cstdint>
#include <cmath>
namespace pg8 {
#define PG8_LAS __attribute__((address_space(3)))
typedef unsigned short bf16_t;
typedef short bf16x8 __attribute__((ext_vector_type(8)));
typedef float f32x4 __attribute__((ext_vector_type(4)));
typedef unsigned u32x4 __attribute__((ext_vector_type(4)));
constexpr int BM = 256, BK = 64, HALF = 128, HTB = HALF * BK * 2  , STAGE_BYTES = 8 * HTB, NXCD = 8, WGM = 8;

__host__ __device__ __forceinline__ int lds_byte(int r, int c) { const int st = (r >> 4) * 2 + (c >> 5), rr = r & 15, cc = c & 31, ob = rr * 64 + cc * 2; return st * 1024 + (ob ^ (((ob >> 9) & 1) << 5)); }
__host__ __device__ __forceinline__ void stage_rc(int b, int& R, int& C) { const int st = b / 1024, sb = b % 1024, swz = sb ^ (((sb >> 9) & 1) << 5); R = (st >> 1) * 16 + swz / 64; C = (st & 1) * 32 + (swz % 64) / 2; }
__host__ __device__ __forceinline__ int perm32(int rho) { const int n = rho >> 4, i = rho & 15; return 8 * (i >> 2) + 4 * n + (i & 3); }

struct Unit { int pm, pn; };
struct Gemm { const bf16_t* A; const bf16_t* Bt; int M, N, K; };

struct StaticOrder {
    int nM, nN, nwg, G, c;
    __host__ __device__ void init(int M, int N, int G_, int c_) { nM = M / BM; nN = N / BM; nwg = nM * nN; G = G_; c = c_; }
    __host__ __device__ bool next(int i, Unit& u) const {
        const long L = (long)i * G + c; if (L >= nwg) return false;
        int wgid = (int)L; { const int q = nwg / NXCD, r = nwg % NXCD, xcd = wgid % NXCD, off = wgid / NXCD; wgid = (xcd < r ? xcd * (q + 1) : r * (q + 1) + (xcd - r) * q) + off; }
        const int nig = WGM * nN, gid = wgid / nig, fm = gid * WGM, gsz = (nM - fm) < WGM ? (nM - fm) : WGM;
        u.pm = fm + ((wgid % nig) % gsz); u.pn = (wgid % nig) / gsz; return true;
    }
    __device__ __forceinline__ void a_ready(const Unit&) const {}
    __device__ __forceinline__ void done(const Unit&) const {}
};

typedef float f32x2_t __attribute__((ext_vector_type(2))); typedef __bf16 bf16x2_t __attribute__((ext_vector_type(2)));
__device__ __forceinline__ unsigned cvt_pk_bf16(float lo, float hi) { f32x2_t v = {lo, hi}; bf16x2_t b = __builtin_convertvector(v, bf16x2_t); return __builtin_bit_cast(unsigned, b); }
typedef float f32x2 __attribute__((ext_vector_type(2)));
__device__ __forceinline__ int row_pos(int r) { return r < 16384 ? (r & 8191) : 8192 + ((r - 16384) & 3); }
struct EpiF32 {
    static constexpr bool PERM = false, AFTER_DRAIN = false;
    float* C; int ldc;
    __device__ __forceinline__ void operator()(const f32x4 (&acc)[2][2][4][2], const Unit& u, int wr, int wc, int fr, int fq) const {
        const int row0 = u.pm * BM + wr * 64 + fr, col0 = u.pn * BM + wc * 32 + 4 * fq;
#pragma unroll
        for (int ai = 0; ai < 2; ++ai)
#pragma unroll
            for (int m = 0; m < 4; ++m) { float* rowp = C + (size_t)(row0 + ai * HALF + m * 16) * ldc + col0;
#pragma unroll
                for (int bj = 0; bj < 2; ++bj)
#pragma unroll
                    for (int n = 0; n < 2; ++n) *(f32x4*)(rowp + bj * HALF + n * 16) = acc[ai][bj][m][n]; }
    }
};
struct EpiBf16P {
    static constexpr bool PERM = true, AFTER_DRAIN = false;
    bf16_t* O; int ldc;
    __device__ __forceinline__ void operator()(const f32x4 (&acc)[2][2][4][2], const Unit& u, int wr, int wc, int fr, int fq) const {
        const int row0 = u.pm * BM + wr * 64 + fr, col0 = u.pn * BM + wc * 32 + 8 * fq;
#pragma unroll
        for (int ai = 0; ai < 2; ++ai)
#pragma unroll
            for (int m = 0; m < 4; ++m) { bf16_t* rowp = O + (size_t)(row0 + ai * HALF + m * 16) * ldc + col0;
#pragma unroll
                for (int bj = 0; bj < 2; ++bj) { const f32x4 v0 = acc[ai][bj][m][0], v1 = acc[ai][bj][m][1];
                    u32x4 w; w.x = cvt_pk_bf16(v0[0], v0[1]); w.y = cvt_pk_bf16(v0[2], v0[3]); w.z = cvt_pk_bf16(v1[0], v1[1]); w.w = cvt_pk_bf16(v1[2], v1[3]);
                    *(u32x4*)(rowp + bj * HALF) = w; } }
    }
};
__device__ __forceinline__ float silu_f(float g) { return g * __builtin_amdgcn_rcpf(1.0f + __builtin_amdgcn_exp2f(-1.4426950408889634f * g)); }
struct EpiSwiGLU {
    static constexpr bool PERM = true, AFTER_DRAIN = false;
    bf16_t* O; int ldc;
    __device__ __forceinline__ void operator()(const f32x4 (&acc)[2][2][4][2], const Unit& u, int wr, int wc, int fr, int fq) const {
        const int row0 = u.pm * BM + wr * 64 + fr, col0 = u.pn * HALF + wc * 32 + 8 * fq;
#pragma unroll
        for (int ai = 0; ai < 2; ++ai)
#pragma unroll
            for (int m = 0; m < 4; ++m) { bf16_t* rowp = O + (size_t)(row0 + ai * HALF + m * 16) * ldc + col0;
                const f32x4 g0 = acc[ai][0][m][0], g1 = acc[ai][0][m][1], u0 = acc[ai][1][m][0], u1 = acc[ai][1][m][1];
                u32x4 w;
                w.x = cvt_pk_bf16(silu_f(g0[0]) * u0[0], silu_f(g0[1]) * u0[1]); w.y = cvt_pk_bf16(silu_f(g0[2]) * u0[2], silu_f(g0[3]) * u0[3]);
                w.z = cvt_pk_bf16(silu_f(g1[0]) * u1[0], silu_f(g1[1]) * u1[1]); w.w = cvt_pk_bf16(silu_f(g1[2]) * u1[2], silu_f(g1[3]) * u1[3]);
                *(u32x4*)rowp = w; }
    }
};
struct EpiQ {
    static constexpr bool PERM = true, AFTER_DRAIN = false;
    bf16_t* O; const float2* rope32; float sc;
    __device__ __forceinline__ void operator()(const f32x4 (&acc)[2][2][4][2], const Unit& u, int wr, int wc, int fr, int fq) const {
        const int row0 = u.pm * BM + wr * 64 + fr, col0 = u.pn * BM + wc * 32 + 8 * fq;
#pragma unroll
        for (int ai = 0; ai < 2; ++ai)
#pragma unroll
            for (int m = 0; m < 4; ++m) { const int r = row0 + ai * HALF + m * 16; bf16_t* rowp = O + (size_t)r * 768 + col0;
                const float2* rt = rope32 + (size_t)row_pos(r) * 16 + 8 * (fq & 1);
#pragma unroll
                for (int bj = 0; bj < 2; ++bj) { f32x4 v0 = acc[ai][bj][m][0], v1 = acc[ai][bj][m][1];
                    const int grp = u.pn * 8 + bj * 4 + wc;
                    if (grp % 3 == 2) {
                        float x[8] = {v0[0], v0[1], v0[2], v0[3], v1[0], v1[1], v1[2], v1[3]};
#pragma unroll
                        for (int e = 0; e < 8; ++e) { const float other = __shfl_xor(x[e], 32); const float2 cs = rt[e];
                            x[e] = (fq < 2) ? (x[e] * cs.x - other * cs.y) : (other * cs.y + x[e] * cs.x); }
                        v0 = (f32x4){x[0], x[1], x[2], x[3]}; v1 = (f32x4){x[4], x[5], x[6], x[7]};
                    }
                    v0 = v0 * sc; v1 = v1 * sc;
                    u32x4 w; w.x = cvt_pk_bf16(v0[0], v0[1]); w.y = cvt_pk_bf16(v0[2], v0[3]); w.z = cvt_pk_bf16(v1[0], v1[1]); w.w = cvt_pk_bf16(v1[2], v1[3]);
                    *(u32x4*)(rowp + bj * HALF) = w; } }
    }
};
template <class Epi, class Sched, bool ALIGN_EPI = false, bool SP2 = false>
__device__ __forceinline__ void gemm_phase(PG8_LAS unsigned char* lds, const Gemm g, const Sched& S, const Epi& E) {
    int tid_ = threadIdx.x; asm volatile("" : "+v"(tid_));
    const int tid = tid_, wid = __builtin_amdgcn_readfirstlane(tid >> 6), lane = tid & 63, wr = wid >> 2, wc = wid & 3, fr = lane & 15, fq = lane >> 4;
    int K_ = g.K; asm volatile("" : "+s"(K_));
    const int K = K_, nt = K / BK;
    unsigned voffA[2], voffB[2];
#pragma unroll
    for (int i = 0; i < 2; ++i) { int R, C; stage_rc(tid * 16 + i * 8192, R, C); const int Rb = Epi::PERM ? ((R & ~31) + perm32(R & 31)) : R;
        voffA[i] = (unsigned)(R * K + C) * 2u; voffB[i] = (unsigned)(Rb * K + C) * 2u; }
    const size_t kstep = (size_t)(BK * 2);
    const size_t hstep = (size_t)HALF * K * 2;
    const size_t tstep = 2 * hstep;
    const unsigned ldsw = (unsigned)wid * 1024u;
    const int aoff = lds_byte(wr * 64 + fr, fq * 8), boff = lds_byte(wc * 32 + fr, fq * 8);
#define PG8_SA(b, h) (((b) * 2 + (h)) * HTB)
#define PG8_SB(b, h) ((4 + (b) * 2 + (h)) * HTB)
#define PG8_STAGE(bufoff, gbase, voff) do { _Pragma("unroll") for (int _i = 0; _i < 2; ++_i) \
        __builtin_amdgcn_global_load_lds((const unsigned*)((const char*)(gbase) + (voff)[_i]), (PG8_LAS unsigned*)(lds + (bufoff) + ldsw + _i * 8192), 16, 0, 0); } while (0)
#define PG8_LDA(dst, b, h) do { _Pragma("unroll") for (int m = 0; m < 4; ++m) _Pragma("unroll") for (int k = 0; k < 2; ++k) dst[m][k] = *(const PG8_LAS bf16x8*)(lds + PG8_SA(b, h) + aoff + m * 2048 + k * 1024); } while (0)
#define PG8_LDB(dst, b, h) do { _Pragma("unroll") for (int n = 0; n < 2; ++n) _Pragma("unroll") for (int k = 0; k < 2; ++k) dst[n][k] = *(const PG8_LAS bf16x8*)(lds + PG8_SB(b, h) + boff + n * 2048 + k * 1024); } while (0)
#define PG8_MMA(ai, bj, At, Bt) do { __builtin_amdgcn_s_setprio(1); _Pragma("unroll") for (int m = 0; m < 4; ++m) _Pragma("unroll") for (int n = 0; n < 2; ++n) _Pragma("unroll") for (int k = 0; k < 2; ++k) \
        acc[ai][bj][m][n] = __builtin_amdgcn_mfma_f32_16x16x32_bf16(Bt[n][k], At[m][k], acc[ai][bj][m][n], 0, 0, 0); __builtin_amdgcn_s_setprio(0); } while (0)
#define PG8_WAIT_V(n) asm volatile("s_waitcnt vmcnt(" #n ")" ::: "memory")
#define PG8_WAIT_L(n) asm volatile("s_waitcnt lgkmcnt(" #n ")" ::: "memory")
#define PG8_BAR __builtin_amdgcn_s_barrier()
#define PG8_SCHED __builtin_amdgcn_sched_barrier(0)
    Unit cur, nxt; int ui = 0;
    if (!S.next(0, cur)) return;
    f32x4 acc[2][2][4][2];
#pragma unroll
    for (int a = 0; a < 2; ++a)
#pragma unroll
        for (int b = 0; b < 2; ++b)
#pragma unroll
            for (int m = 0; m < 4; ++m)
#pragma unroll
                for (int n = 0; n < 2; ++n) acc[a][b][m][n] = (f32x4){0.f, 0.f, 0.f, 0.f};
    bf16x8 At[4][2], B0[2][2], B1[2][2];
    const char* cA = (const char*)g.A + (size_t)cur.pm * tstep; const char* cB = (const char*)g.Bt + (size_t)cur.pn * tstep;
    S.a_ready(cur);
    if constexpr (SP2) {
        PG8_STAGE(PG8_SB(0, 0), cB, voffB); PG8_STAGE(PG8_SB(0, 1), cB + hstep, voffB); PG8_STAGE(PG8_SA(0, 0), cA, voffA); PG8_STAGE(PG8_SA(0, 1), cA + hstep, voffA);
        if (wr == 1) PG8_BAR;
        PG8_WAIT_V(2); PG8_BAR;
        PG8_STAGE(PG8_SB(1, 0), cB + kstep, voffB); PG8_STAGE(PG8_SA(1, 0), cA + kstep, voffA); PG8_STAGE(PG8_SB(1, 1), cB + hstep + kstep, voffB);
        PG8_WAIT_V(6); PG8_BAR;
    } else {
        PG8_STAGE(PG8_SB(0, 0), cB, voffB); PG8_STAGE(PG8_SA(0, 0), cA, voffA); PG8_STAGE(PG8_SB(0, 1), cB + hstep, voffB); PG8_STAGE(PG8_SA(0, 1), cA + hstep, voffA);
        if (wr == 1) PG8_BAR;
        PG8_WAIT_V(4); PG8_BAR;
        PG8_STAGE(PG8_SB(1, 0), cB + kstep, voffB); PG8_STAGE(PG8_SA(1, 0), cA + kstep, voffA); PG8_STAGE(PG8_SB(1, 1), cB + hstep + kstep, voffB);
        PG8_WAIT_V(6); PG8_BAR;
    }
    for (;;) {
        const bool has_next = S.next(ui + 1, nxt);
        const char* nA = has_next ? (const char*)g.A + (size_t)nxt.pm * tstep : cA; const char* nB = has_next ? (const char*)g.Bt + (size_t)nxt.pn * tstep : cB;
        for (int t = 0; t < nt; t += 2) {
            const bool last = (t == nt - 2);
            const char* a1 = cA + (size_t)(t + 1) * kstep;
            const char* a2 = last ? nA : cA + (size_t)(t + 2) * kstep; const char* b2 = last ? nB : cB + (size_t)(t + 2) * kstep;
            const char* a3 = a2 + kstep; const char* b3 = b2 + kstep;
            if (last && has_next) S.a_ready(nxt);
            if constexpr (SP2) {
            PG8_LDB(B0, 0, 0); PG8_LDB(B1, 0, 1); PG8_SCHED; PG8_LDA(At, 0, 0); PG8_STAGE(PG8_SA(1, 1), a1 + hstep, voffA);
            PG8_WAIT_V(8); PG8_WAIT_L(0); PG8_BAR; PG8_MMA(0, 0, At, B0); PG8_MMA(0, 1, At, B1); PG8_BAR; PG8_SCHED;
            PG8_LDA(At, 0, 1); PG8_STAGE(PG8_SB(0, 0), b2, voffB); PG8_STAGE(PG8_SB(0, 1), b2 + hstep, voffB); PG8_STAGE(PG8_SA(0, 0), a2, voffA);
            PG8_WAIT_V(8); PG8_WAIT_L(0); PG8_BAR; PG8_MMA(1, 0, At, B0); PG8_MMA(1, 1, At, B1); PG8_BAR; PG8_SCHED;
            PG8_LDB(B0, 1, 0); PG8_LDB(B1, 1, 1); PG8_SCHED; PG8_LDA(At, 1, 0); PG8_STAGE(PG8_SA(0, 1), a2 + hstep, voffA);
            PG8_WAIT_V(8); PG8_WAIT_L(0); PG8_BAR; PG8_MMA(0, 0, At, B0); PG8_MMA(0, 1, At, B1); PG8_BAR; PG8_SCHED;
            PG8_LDA(At, 1, 1); PG8_STAGE(PG8_SB(1, 0), b3, voffB); PG8_STAGE(PG8_SB(1, 1), b3 + hstep, voffB); PG8_STAGE(PG8_SA(1, 0), a3, voffA);
            PG8_WAIT_V(8); PG8_WAIT_L(0); PG8_BAR; PG8_MMA(1, 0, At, B0); PG8_MMA(1, 1, At, B1); PG8_BAR; PG8_SCHED;
            } else {
            PG8_LDB(B0, 0, 0); PG8_SCHED; PG8_LDA(At, 0, 0); PG8_STAGE(PG8_SA(1, 1), a1 + hstep, voffA);
            PG8_WAIT_L(8); PG8_BAR; PG8_WAIT_L(0); PG8_MMA(0, 0, At, B0); PG8_BAR; PG8_SCHED;
            PG8_LDB(B1, 0, 1); PG8_STAGE(PG8_SB(0, 0), b2, voffB);
            PG8_BAR; PG8_WAIT_L(0); PG8_MMA(0, 1, At, B1); PG8_BAR;
            PG8_LDA(At, 0, 1); PG8_STAGE(PG8_SA(0, 0), a2, voffA);
            PG8_BAR; PG8_WAIT_L(0); PG8_MMA(1, 0, At, B0); PG8_BAR; PG8_SCHED;
            PG8_STAGE(PG8_SB(0, 1), b2 + hstep, voffB);
            PG8_WAIT_V(6); PG8_BAR; PG8_MMA(1, 1, At, B1); PG8_BAR;
            PG8_LDB(B0, 1, 0); PG8_SCHED; PG8_LDA(At, 1, 0); PG8_STAGE(PG8_SA(0, 1), a2 + hstep, voffA);
            PG8_WAIT_L(8); PG8_BAR; PG8_WAIT_L(0); PG8_MMA(0, 0, At, B0); PG8_BAR; PG8_SCHED;
            PG8_LDB(B1, 1, 1); PG8_STAGE(PG8_SB(1, 0), b3, voffB);
            PG8_BAR; PG8_WAIT_L(0); PG8_MMA(0, 1, At, B1); PG8_BAR;
            PG8_LDA(At, 1, 1); PG8_STAGE(PG8_SA(1, 0), a3, voffA);
            PG8_BAR; PG8_WAIT_L(0); PG8_MMA(1, 0, At, B0); PG8_BAR; PG8_SCHED;
            PG8_STAGE(PG8_SB(1, 1), b3 + hstep, voffB);
            PG8_WAIT_V(6); PG8_BAR; PG8_MMA(1, 1, At, B1); PG8_BAR;
            }
        }
        if constexpr (ALIGN_EPI) { if (wr == 0) PG8_BAR; }
        if constexpr (!Epi::AFTER_DRAIN) { E(acc, cur, wr, wc, fr, fq); S.done(cur); }
        if (!has_next) break;
#pragma unroll
        for (int a = 0; a < 2; ++a)
#pragma unroll
            for (int b = 0; b < 2; ++b)
#pragma unroll
                for (int m = 0; m < 4; ++m)
#pragma unroll
                    for (int n = 0; n < 2; ++n) acc[a][b][m][n] = (f32x4){0.f, 0.f, 0.f, 0.f};
        cur = nxt; cA = nA; cB = nB; ++ui;
        if constexpr (ALIGN_EPI) { if (wr == 1) PG8_BAR; }
    }
    PG8_WAIT_V(0);
    if constexpr (!ALIGN_EPI) { if (wr == 0) PG8_BAR; }
    PG8_BAR;
    if constexpr (Epi::AFTER_DRAIN) { E.fused(acc, cur, wr, wc, fr, fq, lds, wid, lane); S.done(cur); }
#undef PG8_SA
#undef PG8_SB
#undef PG8_STAGE
#undef PG8_LDA
#undef PG8_LDB
#undef PG8_MMA
#undef PG8_WAIT_V
#undef PG8_WAIT_L
#undef PG8_BAR
#undef PG8_SCHED
}
}
#define GAS __attribute__((address_space(1)))
#define LAS __attribute__((address_space(3)))
typedef unsigned short bf16;
typedef unsigned v4u __attribute__((ext_vector_type(4)));
typedef float f32x4 __attribute__((ext_vector_type(4)));
typedef short bf16x8 __attribute__((ext_vector_type(8)));
typedef GAS unsigned gu32;
typedef GAS unsigned long long gu64;
#define RLX_AGENT __ATOMIC_RELAXED, __HIP_MEMORY_SCOPE_AGENT
#define LDS_WAIT() asm volatile("s_waitcnt lgkmcnt(0)" ::: "memory")
#define VM_WAIT() asm volatile("s_waitcnt vmcnt(0)" ::: "memory")
__device__ __forceinline__ unsigned long long rt() { return __builtin_amdgcn_s_memrealtime(); }
__device__ __forceinline__ unsigned f2bf(float f) { unsigned u = __builtin_bit_cast(unsigned, f); return (u + 0x7fffu + ((u >> 16) & 1u)) >> 16; }
__device__ __forceinline__ unsigned pk2(float lo, float hi) { return f2bf(lo) | (f2bf(hi) << 16); }

#define XB_TMO      128
#define XB_XCNT(j)  (256  + 64 * (j))
#define XB_XSUB(j)  (1280 + 64 * (j))
#define XB_XGEN(j)  (2304 + 64 * (j))
#define XB_TOP      3328
#define XB_TOPGEN   3392
#define XCD_BAR_WORDS 3456
#define XB_SPIN_CAP (1u << 18)

__device__ __forceinline__ unsigned xb_ld(unsigned* p)              { return __hip_atomic_load(p, __ATOMIC_RELAXED, __HIP_MEMORY_SCOPE_AGENT); }
__device__ __forceinline__ unsigned xb_add(unsigned* p, unsigned v) { return __hip_atomic_fetch_add(p, v, __ATOMIC_RELAXED, __HIP_MEMORY_SCOPE_AGENT); }
__device__ __forceinline__ unsigned xb_xcc_id() { return (unsigned)__builtin_amdgcn_s_getreg((3 << 11) | 20) & 0xFu; }
#define XB_SPIN(cond, bar) do { unsigned _sp = 0; while (cond) { __builtin_amdgcn_s_sleep(1); \
    if ((++_sp & 255u) == 0u) { if (xb_ld(&(bar)[XB_TMO])) break; if (_sp > XB_SPIN_CAP) { atomicAdd(&(bar)[XB_TMO], 1u); break; } } } } while (0)

struct XcdBarrier {
    unsigned* bar; unsigned x;
    volatile LAS unsigned* st;
};

__device__ __forceinline__ XcdBarrier xcd_barrier_post(unsigned* bar, volatile LAS unsigned* st) {
    XcdBarrier b; b.bar = bar; b.x = xb_xcc_id(); b.st = st;
    if (threadIdx.x == 0) (void)xb_add(&bar[XB_XCNT(b.x)], 1u);
    return b;
}
__device__ __forceinline__ void xcd_barrier_complete(unsigned* bar, unsigned x, unsigned& nloc, unsigned& nx) {
    const unsigned G = gridDim.x * gridDim.y * gridDim.z;
    unsigned sum, cnt, mine, sp = 0u;
    for (;;) {
        sum = 0u; cnt = 0u; mine = 0u;
#pragma unroll
        for (unsigned j = 0; j < 16; ++j) { const unsigned c = xb_ld(&bar[XB_XCNT(j)]); sum += c; cnt += (c > 0u) ? 1u : 0u; mine = (j == x) ? c : mine; }
        if (sum == G) break;
        __builtin_amdgcn_s_sleep(1);
        if ((++sp & 255u) == 0u) { if (xb_ld(&bar[XB_TMO])) break; if (sp > XB_SPIN_CAP) { atomicAdd(&bar[XB_TMO], 1u); break; } }
    }
    nloc = mine > 0u ? mine : 1u; nx = cnt > 0u ? cnt : 1u;
}

__device__ __forceinline__ void xcd_barrier(const XcdBarrier& b) {
    asm volatile("s_waitcnt vmcnt(0)" ::: "memory");
    __syncthreads();
    if (threadIdx.x == 0) {
        unsigned* bar = b.bar;
        __builtin_amdgcn_s_waitcnt(0);
        unsigned nloc = b.st[0], nx = b.st[1];
        if (nloc == 0u) { xcd_barrier_complete(bar, b.x, nloc, nx); b.st[0] = nloc; b.st[1] = nx; }
        const unsigned old = xb_add(&bar[XB_XSUB(b.x)], 1u);
        const unsigned gen = old / nloc;
        if (old + 1u == (gen + 1u) * nloc) {
            __builtin_amdgcn_fence(__ATOMIC_RELEASE, "agent");
            asm volatile("s_waitcnt vmcnt(0)" ::: "memory");
            const unsigned og = xb_add(&bar[XB_TOP], 1u);
            const unsigned tg = og / nx;
            if (og + 1u == (tg + 1u) * nx) xb_add(&bar[XB_TOPGEN], 1u);
            else XB_SPIN(xb_ld(&bar[XB_TOPGEN]) == tg, bar);
            __builtin_amdgcn_fence(__ATOMIC_ACQUIRE, "agent");
            xb_add(&bar[XB_XGEN(b.x)], 1u);
            asm volatile("s_waitcnt vmcnt(0)" ::: "memory");
        } else {
            XB_SPIN(xb_ld(&bar[XB_XGEN(b.x)]) == gen, bar);
            __builtin_amdgcn_fence(__ATOMIC_ACQUIRE, "agent");
            asm volatile("s_waitcnt vmcnt(0)" ::: "memory");
        }
    }
    __syncthreads();
}
constexpr int NWAVES = 8;
constexpr int D = 1024, TP = 8192, MP = 16384, NBS = 128, TS = 4, MS = 512, MT = MP + MS;
constexpr int DFF = 2816, NGU = 2 * DFF, DIN = 2848, DINP = 3072;
constexpr int ZQ = 0, ZCKV = 512, ZKPE = 768, ZRQ = 800, ZRK = 1312, ZRV = 1824, ZRG = 2336;
constexpr int NPOS = 8196;
constexpr float ALPHA = 1.4142135623730951f;
constexpr float LN_EPS = 1e-5f, RMS_EPS = 1e-6f;
constexpr float QSCALE = 0.10206207261596575f * 1.4426950408889634f;
constexpr int NSPLIT = 2;
constexpr int PART_F = 64 + 8192;
constexpr size_t OUT_YP = 0, OUT_YS = 16777216, OUT_CKVP = 17301504, OUT_KPEP = 21495808, OUT_CKVS = 22020096, OUT_KPES = 22151168,
                 OUT_RETP = 22167552, OUT_RETS = 22298624, OUT_POOLP = 30687232, OUT_POOLS = 30717952, OUT_TOTAL = 32684032;
constexpr size_t MiB = 1u << 20;
constexpr size_t WS_CTL = 0, CTL_ZERO_BYTES = 1 * MiB;
constexpr size_t WS_ROPE32 = 1 * MiB;
constexpr size_t WS_ROPE128 = WS_ROPE32 + 2 * MiB;
constexpr size_t WS_WGU = WS_ROPE128 + 5 * MiB;
constexpr size_t WS_WD = WS_WGU + 44 * MiB;
constexpr size_t WS_WIN = WS_WD + 22 * MiB;
constexpr size_t WS_WUQ = WS_WIN + 6 * MiB;
constexpr size_t WS_WUKT = WS_WUQ + 1 * MiB;
constexpr size_t WS_WUVT = WS_WUKT + 262144;
constexpr size_t WS_WOUT = WS_WUKT + 1 * MiB;
constexpr size_t WS_WPOOL = WS_WOUT + 2 * MiB;
constexpr size_t WS_XB = WS_WPOOL + 1 * MiB;
constexpr size_t WS_XF = WS_XB + 33 * MiB;
constexpr size_t WS_Y = WS_XF + 66 * MiB;
constexpr size_t WS_HFF = WS_Y + 66 * MiB;
constexpr size_t WS_Z = WS_HFF + 91 * MiB;
constexpr size_t WS_QLN = WS_Z + 99 * MiB;
constexpr size_t WS_CKVN = WS_QLN + 17 * MiB;
constexpr size_t WS_KPEB = WS_CKVN + 9 * MiB;
constexpr size_t WS_RQ = WS_KPEB + 2 * MiB;
constexpr size_t WS_RK = WS_RQ + 17 * MiB;
constexpr size_t WS_Q = WS_RK + 17 * MiB;
constexpr size_t WS_KN = WS_Q + 25 * MiB;
constexpr size_t WS_VT = WS_KN + 16 * MiB;
constexpr size_t WS_MIX = WS_VT + 16 * MiB;
constexpr size_t WS_KVC = WS_MIX + 33 * MiB;
constexpr size_t WS_SST = WS_KVC + 32 * MiB;
constexpr size_t WS_QLAT = WS_SST + 16 * MiB;
constexpr size_t WS_PART = WS_QLAT + 3 * MiB;
constexpr size_t WS_POOLA = WS_PART + 34 * MiB;
constexpr size_t WS_END = WS_POOLA + 33 * MiB;
static_assert((size_t)NBS * NSPLIT * 4 * PART_F * 4 <= 34 * MiB, "PART region");
constexpr int CW_TMO = 0, CW_CODE = 1, CW_BAR = 4096;
constexpr int RING_OFF = 0, RING_BYTES = 131072;
constexpr int LDSCTL_OFF = 155648, MISC_OFF = LDSCTL_OFF + 320;
constexpr int LDS_BYTES = 157696;
static_assert(MISC_OFF + 128 <= LDS_BYTES, "LDS map");

__device__ __forceinline__ float wave_sum(float v) {
#pragma unroll
    for (int o = 1; o < 64; o <<= 1) v += __shfl_xor(v, o);
    return v;
}
__device__ __forceinline__ float bf2f(unsigned short b) { return __uint_as_float((unsigned)b << 16); }
__device__ __forceinline__ float bflo(unsigned w) { return __uint_as_float(w << 16); }
__device__ __forceinline__ float bfhi(unsigned w) { return __uint_as_float(w & 0xffff0000u); }

__device__ __forceinline__ void transpose_item(const float* W, int ldw, bf16* WT, int ldt, int k0, int n0, int drow0, LAS float* scr, int lane) {
#pragma unroll 8
    for (int i = 0; i < 32; ++i) { const int kk = 2 * i + (lane >> 5); scr[kk * 33 + (lane & 31)] = W[(size_t)(k0 + kk) * ldw + n0 + (lane & 31)]; }
    LDS_WAIT(); asm volatile("" ::: "memory");
    const int c = lane & 7;
#pragma unroll
    for (int j = 0; j < 4; ++j) { const int n = (lane >> 3) + 8 * j; const LAS float* s = scr + (8 * c) * 33 + n;
        v4u o; o.x = pk2(s[0 * 33], s[1 * 33]); o.y = pk2(s[2 * 33], s[3 * 33]); o.z = pk2(s[4 * 33], s[5 * 33]); o.w = pk2(s[6 * 33], s[7 * 33]);
        *(GAS v4u*)(WT + (size_t)(drow0 + n) * ldt + k0 + 8 * c) = o; }
    LDS_WAIT(); asm volatile("" ::: "memory");
}

struct Args { const float* in[24]; float* out; unsigned char* ws; int ph_lo, ph_hi; };

__device__ __forceinline__ void p0_prologue(const Args& A, LAS unsigned char* lds, int gw, int NGW, int wave, int lane) {
    unsigned char* ws = A.ws;
    LAS float* scr = (LAS float*)(lds + wave * 16384);
    bf16* WGU = (bf16*)(ws + WS_WGU); bf16* WD = (bf16*)(ws + WS_WD); bf16* WIN = (bf16*)(ws + WS_WIN); bf16* WUQ = (bf16*)(ws + WS_WUQ);
    bf16* WUKT = (bf16*)(ws + WS_WUKT); bf16* WUVT = (bf16*)(ws + WS_WUVT); bf16* WOUT = (bf16*)(ws + WS_WOUT); bf16* WPOOL = (bf16*)(ws + WS_WPOOL);
    constexpr int I_GU = 4 * 2 * 16 * 88, I_D = 4 * 44 * 32, I_IN = 16 * 89, I_UQ = 8 * 24, I_UK = 4 * 16, I_OUT = 16 * 32, I_POOL = 4 * 4 * 8;
    constexpr int NITEMS = I_GU + I_D + I_IN + I_UQ + 2 * I_UK + I_OUT + I_POOL;
    for (int it = gw; it < NITEMS; it += NGW) {
        int r = it;
        if (r < I_GU) { const int lm = r / 2816; r -= lm * 2816; const int up = r / 1408; r -= up * 1408; const int kb = r / 88, n0 = (r % 88) * 32;
            transpose_item((up ? A.in[8] : A.in[7]) + (size_t)lm * D * DFF, DFF, WGU + (size_t)lm * NGU * D, D, kb * 64, n0, (n0 / 128) * 256 + (n0 % 128) + up * 128, scr, lane); continue; }
        r -= I_GU;
        if (r < I_D) { const int lm = r / 1408; r -= lm * 1408; const int kb = r / 32, n0 = (r % 32) * 32;
            transpose_item(A.in[9] + (size_t)lm * DFF * D, D, WD + (size_t)lm * D * DFF, DFF, kb * 64, n0, n0, scr, lane); continue; }
        r -= I_D;
        if (r < I_IN) { const int kb = r / 89, n0 = (r % 89) * 32; transpose_item(A.in[12], DIN, WIN, D, kb * 64, n0, n0, scr, lane); continue; }
        r -= I_IN;
        if (r < I_UQ) { const int kb = r / 24, n0 = (r % 24) * 32; transpose_item(A.in[15], 768, WUQ, 512, kb * 64, n0, n0, scr, lane); continue; }
        r -= I_UQ;
        if (r < I_UK) { const int kb = r / 16, n0 = (r % 16) * 32; transpose_item(A.in[16], 512, WUKT, 256, kb * 64, n0, n0, scr, lane); continue; }
        r -= I_UK;
        if (r < I_UK) { const int kb = r / 16, n0 = (r % 16) * 32; transpose_item(A.in[17], 512, WUVT, 256, kb * 64, n0, n0, scr, lane); continue; }
        r -= I_UK;
        if (r < I_OUT) { const int kb = r / 32, n0 = (r % 32) * 32; transpose_item(A.in[20], D, WOUT, D, kb * 64, n0, n0, scr, lane); continue; }
        r -= I_OUT;
        { const int g = r / 32; r -= g * 32; const int kb = r / 8, n0 = (r % 8) * 32; transpose_item(A.in[21] + (size_t)g * 65536, 256, WPOOL + (size_t)g * 65536, 256, kb * 64, n0, n0, scr, lane); }
    }
    { GAS v4u* z = (GAS v4u*)(WIN + (size_t)DIN * D); const int n16 = (DINP - DIN) * D * 2 / 16;
      for (int i = gw * 64 + lane; i < n16; i += NGW * 64) z[i] = (v4u){0u, 0u, 0u, 0u}; }
    { bf16* XB = (bf16*)(ws + WS_XB);
      for (int m = gw; m < MT; m += NGW) { const float* xr = (m < MP) ? A.in[0] + (size_t)m * D : A.in[1] + (size_t)(m - MP) * D;
          const GAS f32x4* x4 = (const GAS f32x4*)xr + lane; GAS unsigned long long* o8 = (GAS unsigned long long*)(XB + (size_t)m * D) + lane;
#pragma unroll
          for (int j = 0; j < 4; ++j) { const f32x4 v = x4[64 * j]; o8[64 * j] = (unsigned long long)pk2(v.x, v.y) | ((unsigned long long)pk2(v.z, v.w) << 32); } } }
    { float2* R32 = (float2*)(ws + WS_ROPE32); float2* R128 = (float2*)(ws + WS_ROPE128);
      for (int i = gw * 64 + lane; i < NPOS * 80; i += NGW * 64) { const int pos = i / 80, k = i % 80;
          const bool small = k < 16; const int idx = small ? k : k - 16; const float rr = small ? 32.f : 128.f;
          const float inv = 1.0f / powf(10000.0f, (float)(2 * idx) / rr); const float ang = (float)pos * inv;
          const float2 cs = make_float2(cosf(ang), sinf(ang));
          if (small) R32[pos * 16 + idx] = cs; else R128[pos * 64 + idx] = cs; } }
}

__device__ __forceinline__ void ln_phase(const Args& A, const float* hres, const float* Y, float ysc, const float* cb, const float* cs, const float* gain, const float* bias, float* outF, bf16* outB, int gw, int NGW, int lane) {
    const GAS f32x4* g4 = (const GAS f32x4*)gain + lane; const GAS f32x4* b4 = (const GAS f32x4*)bias + lane;
    f32x4 g[4], b[4];
#pragma unroll
    for (int j = 0; j < 4; ++j) { g[j] = g4[64 * j]; b[j] = b4[64 * j]; }
    f32x4 cbv[4], csv[4];
#pragma unroll
    for (int j = 0; j < 4; ++j) { cbv[j] = cb ? ((const GAS f32x4*)cb + lane)[64 * j] : (f32x4){0.f, 0.f, 0.f, 0.f}; csv[j] = cs ? ((const GAS f32x4*)cs + lane)[64 * j] * ysc : (f32x4){ysc, ysc, ysc, ysc}; }
    for (int m = gw; m < MT; m += NGW) {
        const float* hr = hres ? hres + (size_t)m * D : ((m < MP) ? A.in[0] + (size_t)m * D : A.in[1] + (size_t)(m - MP) * D);
        const GAS f32x4* h4 = (const GAS f32x4*)hr + lane; const GAS f32x4* y4 = (const GAS f32x4*)(Y + (size_t)m * D) + lane;
        f32x4 v[4]; float s = 0.f;
#pragma unroll
        for (int j = 0; j < 4; ++j) { v[j] = h4[64 * j] * ALPHA + (y4[64 * j] + cbv[j]) * csv[j]; s += (v[j].x + v[j].y) + (v[j].z + v[j].w); }
        const float mean = wave_sum(s) * (1.f / D); float s2 = 0.f;
#pragma unroll
        for (int j = 0; j < 4; ++j) { v[j] = v[j] - mean; s2 += (v[j].x * v[j].x + v[j].y * v[j].y) + (v[j].z * v[j].z + v[j].w * v[j].w); }
        const float rstd = 1.f / sqrtf(wave_sum(s2) * (1.f / D) + LN_EPS);
        GAS f32x4* o4 = (GAS f32x4*)(outF + (size_t)m * D) + lane; GAS unsigned long long* o8 = (GAS unsigned long long*)(outB + (size_t)m * D) + lane;
#pragma unroll
        for (int j = 0; j < 4; ++j) { const f32x4 o = v[j] * rstd * g[j] + b[j]; o4[64 * j] = o;
            o8[64 * j] = (unsigned long long)pk2(o.x, o.y) | ((unsigned long long)pk2(o.z, o.w) << 32); }
    }
}

__device__ __forceinline__ void post_phase(const Args& A, int gw, int NGW, int lane) {
    unsigned char* ws = A.ws;
    const bf16* Z = (const bf16*)(ws + WS_Z); bf16* QLN = (bf16*)(ws + WS_QLN); bf16* CKVN = (bf16*)(ws + WS_CKVN); bf16* KPEB = (bf16*)(ws + WS_KPEB);
    bf16* RQ = (bf16*)(ws + WS_RQ); bf16* RK = (bf16*)(ws + WS_RK);
    const float2* R32 = (const float2*)(ws + WS_ROPE32); const float2* R128 = (const float2*)(ws + WS_ROPE128);
    const float* qg = A.in[13]; const float* kg = A.in[14];
    for (int m = gw; m < MT; m += NGW) {
        const bf16* z = Z + (size_t)m * DINP; const int pos = pg8::row_pos(m);
        { const v4u w = *(const GAS v4u*)(z + ZQ + 8 * lane);
          float x[8] = {bflo(w.x), bfhi(w.x), bflo(w.y), bfhi(w.y), bflo(w.z), bfhi(w.z), bflo(w.w), bfhi(w.w)};
          float s = 0.f;
#pragma unroll
          for (int e = 0; e < 8; ++e) s += x[e] * x[e];
          const float r = 1.0f / sqrtf(wave_sum(s) * (1.f / 512.f) + RMS_EPS);
          const f32x4 g0 = *(const GAS f32x4*)(qg + 8 * lane), g1 = *(const GAS f32x4*)(qg + 8 * lane + 4);
          v4u o; o.x = pk2(x[0] * r * g0.x, x[1] * r * g0.y); o.y = pk2(x[2] * r * g0.z, x[3] * r * g0.w); o.z = pk2(x[4] * r * g1.x, x[5] * r * g1.y); o.w = pk2(x[6] * r * g1.z, x[7] * r * g1.w);
          *(GAS v4u*)(QLN + (size_t)m * 512 + 8 * lane) = o; }
        { const unsigned long long w = *(const GAS unsigned long long*)(z + ZCKV + 4 * lane); const unsigned w0 = (unsigned)w, w1 = (unsigned)(w >> 32);
          float x[4] = {bflo(w0), bfhi(w0), bflo(w1), bfhi(w1)};
          const float s = (x[0] * x[0] + x[1] * x[1]) + (x[2] * x[2] + x[3] * x[3]);
          const float r = 1.0f / sqrtf(wave_sum(s) * (1.f / 256.f) + RMS_EPS);
          const f32x4 g0 = *(const GAS f32x4*)(kg + 4 * lane);
          const f32x4 o = (f32x4){x[0] * r * g0.x, x[1] * r * g0.y, x[2] * r * g0.z, x[3] * r * g0.w};
          float* outp = A.out + ((m < MP) ? OUT_CKVP + (size_t)m * 256 : OUT_CKVS + (size_t)(m - MP) * 256);
          *(GAS f32x4*)(outp + 4 * lane) = o;
          *(GAS unsigned long long*)(CKVN + (size_t)m * 256 + 4 * lane) = (unsigned long long)pk2(o.x, o.y) | ((unsigned long long)pk2(o.z, o.w) << 32); }
        if (lane < 16) { const float x1 = bf2f(z[ZKPE + lane]), x2 = bf2f(z[ZKPE + 16 + lane]); const float2 cs = R32[pos * 16 + lane];
          const float o1 = x1 * cs.x - x2 * cs.y, o2 = x1 * cs.y + x2 * cs.x;
          float* outp = A.out + ((m < MP) ? OUT_KPEP + (size_t)m * 32 : OUT_KPES + (size_t)(m - MP) * 32);
          outp[lane] = o1; outp[16 + lane] = o2; KPEB[(size_t)m * 32 + lane] = (bf16)f2bf(o1); KPEB[(size_t)m * 32 + 16 + lane] = (bf16)f2bf(o2); }
        { const float2 cs = R128[pos * 64 + lane];
#pragma unroll
          for (int h = 0; h < 4; ++h) {
              const float q1 = bf2f(z[ZRQ + h * 128 + lane]), q2 = bf2f(z[ZRQ + h * 128 + 64 + lane]);
              RQ[(size_t)m * 512 + h * 128 + lane] = (bf16)f2bf(q1 * cs.x - q2 * cs.y); RQ[(size_t)m * 512 + h * 128 + 64 + lane] = (bf16)f2bf(q1 * cs.y + q2 * cs.x);
              const float k1 = bf2f(z[ZRK + h * 128 + lane]), k2 = bf2f(z[ZRK + h * 128 + 64 + lane]); const float ks = 0.08838834764831845f;
              RK[(size_t)m * 512 + h * 128 + lane] = (bf16)f2bf((k1 * cs.x - k2 * cs.y) * ks); RK[(size_t)m * 512 + h * 128 + 64 + lane] = (bf16)f2bf((k1 * cs.y + k2 * cs.x) * ks); } }
    }
}
typedef float f32x16 __attribute__((ext_vector_type(16)));
typedef short s16x4 __attribute__((ext_vector_type(4)));
typedef unsigned u32x2 __attribute__((ext_vector_type(2)));
__device__ __forceinline__ int crow(int r, int hi) { return (r & 3) + 8 * (r >> 2) + 4 * hi; }
__device__ __forceinline__ unsigned cvtpk(float lo, float hi) { return pg8::cvt_pk_bf16(lo, hi); }
__device__ __forceinline__ bf16x8 pack8(const f32x16& p, int b) {
    v4u w; w.x = cvtpk(p[b], p[b + 1]); w.y = cvtpk(p[b + 2], p[b + 3]); w.z = cvtpk(p[b + 4], p[b + 5]); w.w = cvtpk(p[b + 6], p[b + 7]);
    return __builtin_bit_cast(bf16x8, w);
}
__device__ __forceinline__ bf16x8 join44(s16x4 a, s16x4 b) { return (bf16x8){a[0], a[1], a[2], a[3], b[0], b[1], b[2], b[3]}; }
typedef short v4i16_t __attribute__((ext_vector_type(4)));
__device__ __forceinline__ s16x4 ldtr(const LAS unsigned char* p) { return __builtin_bit_cast(s16x4, __builtin_amdgcn_ds_read_tr16_b64_v4i16((LAS v4i16_t*)p)); }

constexpr int AK_STRIDE = 208, AV_STRIDE = 136, AK_BYTES = 64 * AK_STRIDE, AV_BYTES = 64 * AV_STRIDE;
__device__ __forceinline__ void attn_unit_prompt(const bf16* Q, const bf16* KN, const bf16* KPEB, const bf16* VT, bf16* MIX, int b, int h, int qb, LAS unsigned char* lds, int tid, int wave, int lane) {
    const int r32 = lane & 31, hi = lane >> 5;
    const int qloc = qb * 256 + wave * 32 + r32;
    const size_t qrow = (size_t)b * TP + qloc;
    bf16x8 qr[6];
#pragma unroll
    for (int s = 0; s < 6; ++s) qr[s] = *(const GAS bf16x8*)(Q + qrow * 768 + h * 96 + 16 * s + 8 * hi);
    const int NT = 4 * (qb + 1);
    const int kc0 = tid, kc1 = tid + 512; const bool k1v = kc1 < 768;
    const int kr0 = kc0 / 12, kh0 = kc0 % 12, kr1 = k1v ? kc1 / 12 : 0, kh1 = k1v ? kc1 % 12 : 0;
    const int vr = tid >> 3, vh = tid & 7;
    const bf16* kbase = KN + (size_t)b * TP * 512 + h * 64; const bf16* pbase = KPEB + (size_t)b * TP * 32; const bf16* vbase = VT + (size_t)(h * 64 + vr) * MP + (size_t)b * TP + vh * 8;
    v4u gk0, gk1, gv;
#define ATT_LOAD(t) do { const int t0_ = (t) * 64; \
        gk0 = (kh0 < 8) ? *(const GAS v4u*)(kbase + (size_t)(t0_ + kr0) * 512 + kh0 * 8) : *(const GAS v4u*)(pbase + (size_t)(t0_ + kr0) * 32 + (kh0 - 8) * 8); \
        if (k1v) gk1 = (kh1 < 8) ? *(const GAS v4u*)(kbase + (size_t)(t0_ + kr1) * 512 + kh1 * 8) : *(const GAS v4u*)(pbase + (size_t)(t0_ + kr1) * 32 + (kh1 - 8) * 8); \
        gv = *(const GAS v4u*)(vbase + t0_); } while (0)
#define ATT_STORE(buf) do { LAS unsigned char* kb_ = lds + (buf) * AK_BYTES; LAS unsigned char* vb_ = lds + 2 * AK_BYTES + (buf) * AV_BYTES; \
        *(LAS v4u*)(kb_ + kr0 * AK_STRIDE + kh0 * 16) = gk0; if (k1v) *(LAS v4u*)(kb_ + kr1 * AK_STRIDE + kh1 * 16) = gk1; \
        *(LAS u32x2*)(vb_ + vr * AV_STRIDE + vh * 16) = (u32x2){gv.x, gv.y}; *(LAS u32x2*)(vb_ + vr * AV_STRIDE + vh * 16 + 8) = (u32x2){gv.z, gv.w}; } while (0)
    float m_run = -INFINITY, l_run = 0.f; f32x16 o0, o1;
#pragma unroll
    for (int r = 0; r < 16; ++r) { o0[r] = 0.f; o1[r] = 0.f; }
    ATT_LOAD(0); ATT_STORE(0); __syncthreads();
    const int qmaxw = qb * 256 + wave * 32 + 31;
    for (int t = 0; t < NT; ++t) {
        const bool more = (t + 1 < NT);
        if (more) ATT_LOAD(t + 1);
        if (64 * t <= qmaxw) {
            const LAS unsigned char* kb = lds + (t & 1) * AK_BYTES; const LAS unsigned char* vb = lds + 2 * AK_BYTES + (t & 1) * AV_BYTES;
            f32x16 p0, p1;
#pragma unroll
            for (int r = 0; r < 16; ++r) { p0[r] = 0.f; p1[r] = 0.f; }
#pragma unroll
            for (int s = 0; s < 6; ++s) {
                const bf16x8 a0 = *(const LAS bf16x8*)(kb + r32 * AK_STRIDE + 32 * s + 16 * hi);
                const bf16x8 a1 = *(const LAS bf16x8*)(kb + (32 + r32) * AK_STRIDE + 32 * s + 16 * hi);
                p0 = __builtin_amdgcn_mfma_f32_32x32x16_bf16(a0, qr[s], p0, 0, 0, 0);
                p1 = __builtin_amdgcn_mfma_f32_32x32x16_bf16(a1, qr[s], p1, 0, 0, 0);
            }
            if (64 * t + 63 > qb * 256 + wave * 32) {
#pragma unroll
                for (int r = 0; r < 16; ++r) { const int kv = 64 * t + crow(r, hi); if (kv > qloc) p0[r] = -INFINITY; if (kv + 32 > qloc) p1[r] = -INFINITY; }
            }
            float mx = fmaxf(p0[0], p1[0]);
#pragma unroll
            for (int r = 1; r < 16; ++r) mx = fmaxf(mx, fmaxf(p0[r], p1[r]));
            mx = fmaxf(mx, __shfl_xor(mx, 32));
            const float m_new = fmaxf(m_run, mx); const float alpha = __builtin_amdgcn_exp2f(m_run - m_new); m_run = m_new;
            float ps = 0.f;
#pragma unroll
            for (int r = 0; r < 16; ++r) { p0[r] = __builtin_amdgcn_exp2f(p0[r] - m_new); p1[r] = __builtin_amdgcn_exp2f(p1[r] - m_new); ps += p0[r] + p1[r]; }
            l_run = l_run * alpha + ps;
#pragma unroll
            for (int r = 0; r < 16; ++r) { o0[r] *= alpha; o1[r] *= alpha; }
            const bf16x8 pb0 = pack8(p0, 0), pb1 = pack8(p0, 8), pb2 = pack8(p1, 0), pb3 = pack8(p1, 8);
#pragma unroll
            for (int ks = 0; ks < 4; ++ks) {
                const bf16x8 pb = ks == 0 ? pb0 : ks == 1 ? pb1 : ks == 2 ? pb2 : pb3;
                const LAS unsigned char* va = vb + r32 * AV_STRIDE + (16 * ks + 4 * hi) * 2;
                const bf16x8 v0 = join44(*(const LAS s16x4*)(va), *(const LAS s16x4*)(va + 16));
                const bf16x8 v1 = join44(*(const LAS s16x4*)(va + 32 * AV_STRIDE), *(const LAS s16x4*)(va + 32 * AV_STRIDE + 16));
                o0 = __builtin_amdgcn_mfma_f32_32x32x16_bf16(v0, pb, o0, 0, 0, 0);
                o1 = __builtin_amdgcn_mfma_f32_32x32x16_bf16(v1, pb, o1, 0, 0, 0);
            }
        }
        if (more) ATT_STORE((t + 1) & 1);
        __syncthreads();
    }
#undef ATT_LOAD
#undef ATT_STORE
    const float lt = l_run + __shfl_xor(l_run, 32); const float il = 1.0f / lt;
    bf16* orow = MIX + qrow * D + h * 64;
#pragma unroll
    for (int g = 0; g < 4; ++g) {
        *(GAS u32x2*)(orow + 8 * g + 4 * hi) = (u32x2){pk2(o0[4 * g] * il, o0[4 * g + 1] * il), pk2(o0[4 * g + 2] * il, o0[4 * g + 3] * il)};
        *(GAS u32x2*)(orow + 32 + 8 * g + 4 * hi) = (u32x2){pk2(o1[4 * g] * il, o1[4 * g + 1] * il), pk2(o1[4 * g + 2] * il, o1[4 * g + 3] * il)};
    }
}

__device__ __forceinline__ float ret_log2g(int h) { return log2f(1.0f - exp2f(-5.0f - (float)h)); }
constexpr int RS_TR = 320, RS_ROW = 272;
__device__ __forceinline__ void ret_a_unit(const bf16* RK, const bf16* Z, float* KVC, int bh, int c, LAS unsigned char* lds, int tid, int wave, int lane) {
    const int b = bh >> 2, h = bh & 3; const size_t row0 = (size_t)b * TP + (size_t)c * 128; const float l2g = ret_log2g(h);
    LAS unsigned char* KT = lds; LAS unsigned char* VTl = lds + 128 * RS_TR;
#pragma unroll
    for (int i = 0; i < 4; ++i) { const int cid = tid + 512 * i, j = cid >> 4, ch = cid & 15;
        const v4u kk = *(const GAS v4u*)(RK + (row0 + j) * 512 + h * 128 + ch * 8);
        *(LAS v4u*)(KT + j * RS_TR + ch * 16) = kk;
        const v4u vv = *(const GAS v4u*)(Z + (row0 + j) * DINP + ZRV + h * 128 + ch * 8);
        const float sc = exp2f(l2g * (float)(127 - j));
        v4u o; o.x = pk2(bflo(vv.x) * sc, bfhi(vv.x) * sc); o.y = pk2(bflo(vv.y) * sc, bfhi(vv.y) * sc); o.z = pk2(bflo(vv.z) * sc, bfhi(vv.z) * sc); o.w = pk2(bflo(vv.w) * sc, bfhi(vv.w) * sc);
        *(LAS v4u*)(VTl + j * RS_TR + ch * 16) = o; }
    __syncthreads();
    const int r32 = lane & 31, hi = lane >> 5, g1 = (lane >> 4) & 1, q4 = (lane & 15) >> 2, p4 = lane & 3;
    const int mb = wave >> 1, nb0 = (wave & 1) * 2;
    f32x16 a0, a1;
#pragma unroll
    for (int r = 0; r < 16; ++r) { a0[r] = 0.f; a1[r] = 0.f; }
    const int laneoff = (8 * hi + q4) * RS_TR + (16 * g1 + 4 * p4) * 2;
#pragma unroll
    for (int s = 0; s < 8; ++s) {
        const LAS unsigned char* ka = KT + laneoff + s * 16 * RS_TR + mb * 64;
        const bf16x8 af = join44(ldtr(ka), ldtr(ka + 4 * RS_TR));
        const LAS unsigned char* va = VTl + laneoff + s * 16 * RS_TR + nb0 * 64;
        const bf16x8 b0 = join44(ldtr(va), ldtr(va + 4 * RS_TR));
        const bf16x8 b1 = join44(ldtr(va + 64), ldtr(va + 64 + 4 * RS_TR));
        a0 = __builtin_amdgcn_mfma_f32_32x32x16_bf16(af, b0, a0, 0, 0, 0);
        a1 = __builtin_amdgcn_mfma_f32_32x32x16_bf16(af, b1, a1, 0, 0, 0);
    }
    float* outp = KVC + ((size_t)bh * 64 + c) * 16384;
#pragma unroll
    for (int r = 0; r < 16; ++r) { const int dk = mb * 32 + crow(r, hi);
        outp[dk * 128 + nb0 * 32 + r32] = a0[r]; outp[dk * 128 + (nb0 + 1) * 32 + r32] = a1[r]; }
    __syncthreads();
}
__device__ __forceinline__ void ret_scan(const float* KVC, bf16* SST, float* outRet, int gtid, int gthreads) {
    for (int e = gtid; e < 8 * 16384; e += gthreads) {
        const int bh = e >> 14, idx = e & 16383, h = bh & 3; const float l2g = ret_log2g(h); const float g1 = exp2f(l2g), gc = exp2f(l2g * 128.f);
        float s = 0.f; const float* kv = KVC + (size_t)bh * 64 * 16384 + idx; bf16* st = SST + (size_t)bh * 64 * 16384 + idx;
#pragma unroll 8
        for (int c = 0; c < 64; ++c) { st[(size_t)c * 16384] = (bf16)f2bf(s * g1); s = s * gc + kv[(size_t)c * 16384]; }
        outRet[(size_t)bh * 16384 + idx] = s;
    }
}
__device__ __forceinline__ void ret_c_unit(const bf16* RQ, const bf16* RK, const bf16* Z, const bf16* SST, const float* gng, const float* gnb, bf16* MIX, int bh, int c, LAS unsigned char* lds, int tid, int wave, int lane) {
    const int b = bh >> 2, h = bh & 3; const size_t row0 = (size_t)b * TP + (size_t)c * 128; const float l2g = ret_log2g(h);
    LAS unsigned char* KH = lds;
    LAS unsigned char* VV = lds + 128 * RS_ROW;
    LAS unsigned char* SS = VV + 128 * RS_TR;
    LAS float* XS = (LAS float*)(SS + 128 * RS_TR);
    const bf16* sst = SST + ((size_t)bh * 64 + c) * 16384;
#pragma unroll
    for (int i = 0; i < 4; ++i) { const int cid = tid + 512 * i, j = cid >> 4, ch = cid & 15;
        const v4u kk = *(const GAS v4u*)(RK + (row0 + j) * 512 + h * 128 + ch * 8); const float sc = exp2f(-l2g * (float)j);
        v4u o; o.x = pk2(bflo(kk.x) * sc, bfhi(kk.x) * sc); o.y = pk2(bflo(kk.y) * sc, bfhi(kk.y) * sc); o.z = pk2(bflo(kk.z) * sc, bfhi(kk.z) * sc); o.w = pk2(bflo(kk.w) * sc, bfhi(kk.w) * sc);
        *(LAS v4u*)(KH + j * RS_ROW + ch * 16) = o;
        *(LAS v4u*)(VV + j * RS_TR + ch * 16) = *(const GAS v4u*)(Z + (row0 + j) * DINP + ZRV + h * 128 + ch * 8);
        *(LAS v4u*)(SS + j * RS_TR + ch * 16) = *(const GAS v4u*)(sst + j * 128 + ch * 8); }
    const int r32 = lane & 31, hi = lane >> 5, g1 = (lane >> 4) & 1, q4 = (lane & 15) >> 2, p4 = lane & 3;
    const int ib = wave >> 1, db0 = (wave & 1) * 2;
    const int iloc = ib * 32 + r32;
    bf16x8 qf[8];
#pragma unroll
    for (int s = 0; s < 8; ++s) qf[s] = *(const GAS bf16x8*)(RQ + (row0 + iloc) * 512 + h * 128 + 16 * s + 8 * hi);
    __syncthreads();
    f32x16 o0, o1;
#pragma unroll
    for (int r = 0; r < 16; ++r) { o0[r] = 0.f; o1[r] = 0.f; }
    const int laneoff = (8 * hi + q4) * RS_TR + (16 * g1 + 4 * p4) * 2;
#pragma unroll
    for (int s = 0; s < 8; ++s) {
        const LAS unsigned char* sa = SS + laneoff + s * 16 * RS_TR + db0 * 64;
        const bf16x8 s0 = join44(ldtr(sa), ldtr(sa + 4 * RS_TR));
        const bf16x8 s1 = join44(ldtr(sa + 64), ldtr(sa + 64 + 4 * RS_TR));
        o0 = __builtin_amdgcn_mfma_f32_32x32x16_bf16(s0, qf[s], o0, 0, 0, 0);
        o1 = __builtin_amdgcn_mfma_f32_32x32x16_bf16(s1, qf[s], o1, 0, 0, 0);
    }
    const int laneoffp = (4 * hi + q4) * RS_TR + (16 * g1 + 4 * p4) * 2;
    for (int jb = 0; jb <= ib; ++jb) {
        f32x16 sc;
#pragma unroll
        for (int r = 0; r < 16; ++r) sc[r] = 0.f;
#pragma unroll
        for (int s = 0; s < 8; ++s) {
            const bf16x8 kf = *(const LAS bf16x8*)(KH + (jb * 32 + r32) * RS_ROW + 32 * s + 16 * hi);
            sc = __builtin_amdgcn_mfma_f32_32x32x16_bf16(kf, qf[s], sc, 0, 0, 0);
        }
        if (jb == ib) {
#pragma unroll
            for (int r = 0; r < 16; ++r) if (crow(r, hi) > r32) sc[r] = 0.f;
        }
        const bf16x8 pb0 = pack8(sc, 0), pb1 = pack8(sc, 8);
#pragma unroll
        for (int ks = 0; ks < 2; ++ks) {
            const bf16x8 pb = ks == 0 ? pb0 : pb1;
            const LAS unsigned char* va = VV + laneoffp + (jb * 32 + ks * 16) * RS_TR + db0 * 64;
            const bf16x8 v0 = join44(ldtr(va), ldtr(va + 8 * RS_TR));
            const bf16x8 v1 = join44(ldtr(va + 64), ldtr(va + 64 + 8 * RS_TR));
            o0 = __builtin_amdgcn_mfma_f32_32x32x16_bf16(v0, pb, o0, 0, 0, 0);
            o1 = __builtin_amdgcn_mfma_f32_32x32x16_bf16(v1, pb, o1, 0, 0, 0);
        }
    }
    const float gi = exp2f(l2g * (float)iloc);
    float s1 = 0.f;
#pragma unroll
    for (int r = 0; r < 16; ++r) { o0[r] *= gi; o1[r] *= gi; s1 += o0[r] + o1[r]; }
    s1 += __shfl_xor(s1, 32);
    if (hi == 0) XS[wave * 32 + r32] = s1;
    __syncthreads();
    const float mean = (XS[wave * 32 + r32] + XS[(wave ^ 1) * 32 + r32]) * (1.f / 128.f);
    float s2 = 0.f;
#pragma unroll
    for (int r = 0; r < 16; ++r) { o0[r] -= mean; o1[r] -= mean; s2 += o0[r] * o0[r] + o1[r] * o1[r]; }
    s2 += __shfl_xor(s2, 32);
    __syncthreads();
    if (hi == 0) XS[wave * 32 + r32] = s2;
    __syncthreads();
    const float rstd = 1.0f / sqrtf((XS[wave * 32 + r32] + XS[(wave ^ 1) * 32 + r32]) * (1.f / 128.f) + LN_EPS);
    const size_t m = row0 + iloc;
    const bf16* zg = Z + m * DINP + ZRG + h * 128; bf16* orow = MIX + m * D + 512 + h * 128;
#pragma unroll
    for (int half = 0; half < 2; ++half)
#pragma unroll
        for (int g = 0; g < 4; ++g) { const int dv = (db0 + half) * 32 + 8 * g + 4 * hi;
            const f32x4 gg = *(const GAS f32x4*)(gng + h * 128 + dv), bb = *(const GAS f32x4*)(gnb + h * 128 + dv);
            const u32x2 gz = *(const GAS u32x2*)(zg + dv);
            const float gt[4] = {bflo(gz.x), bfhi(gz.x), bflo(gz.y), bfhi(gz.y)};
            float ov[4];
#pragma unroll
            for (int e = 0; e < 4; ++e) { const float x = half == 0 ? o0[4 * g + e] : o1[4 * g + e]; ov[e] = (x * rstd * gg[e] + bb[e]) * pg8::silu_f(gt[e]); }
            *(GAS u32x2*)(orow + dv) = (u32x2){pk2(ov[0], ov[1]), pk2(ov[2], ov[3])}; }
    __syncthreads();
}
constexpr int SI_STRIDE = 592;
constexpr int SI_IMG = 32 * SI_STRIDE;
constexpr int SI_Q = 4 * SI_IMG;
__device__ __forceinline__ void s_absorb_unit(const bf16* Q, const float* w_uk, bf16* QLAT, int b, LAS unsigned char* lds, int tid) {
    LAS float* qs = (LAS float*)lds;
    for (int i = tid; i < 4 * 768; i += 512) qs[i] = bf2f(Q[(size_t)(MP + b * 4) * 768 + i]);
    __syncthreads();
    const int c = tid & 255, hg = tid >> 8;
    bf16* ql = QLAT + (size_t)b * 32 * 288;
    for (int hh = 0; hh < 4; ++hh) { const int h = hg * 4 + hh; float acc[4] = {0.f, 0.f, 0.f, 0.f};
        const float* w = w_uk + (size_t)c * 512 + h * 64;
#pragma unroll 4
        for (int d = 0; d < 64; d += 4) { const f32x4 w4 = *(const GAS f32x4*)(w + d);
#pragma unroll
            for (int t = 0; t < 4; ++t) { const LAS float* q = qs + t * 768 + h * 96 + d; acc[t] += w4.x * q[0] + w4.y * q[1] + w4.z * q[2] + w4.w * q[3]; } }
#pragma unroll
        for (int t = 0; t < 4; ++t) ql[(h * 4 + t) * 288 + c] = (bf16)f2bf(acc[t]); }
    for (int i = tid; i < 1024; i += 512) { const int rho = i >> 5, e = i & 31, h = rho >> 2, t = rho & 3; ql[rho * 288 + 256 + e] = (bf16)f2bf(qs[t * 768 + h * 96 + 64 + e]); }
    __syncthreads();
}
__device__ __forceinline__ void s_attn_unit(const float* cckv, const float* ckpe, const int* ptab, const bf16* QLAT, float* PART, int b, int sp, LAS unsigned char* lds, int tid, int wave, int lane) {
    constexpr int NHP = 2 * 64 / NSPLIT;
    const int r32 = lane & 31, hi = lane >> 5, g1 = (lane >> 4) & 1, q4 = (lane & 15) >> 2, p4 = lane & 3;
    const int im = wave >> 2, qt = wave & 3;
    for (int i = tid; i < 32 * 36; i += 512) { const int row = i / 36, ch = i % 36; *(LAS v4u*)(lds + SI_Q + row * SI_STRIDE + ch * 16) = *(const GAS v4u*)(QLAT + (size_t)b * 32 * 288 + row * 288 + ch * 8); }
    f32x4 R[9];
    const int* pt = ptab + b * 64 + sp * (64 / NSPLIT);
    const int st_c = wave * SI_STRIDE + (tid & 63) * 8, st_k = (tid >> 3) * SI_STRIDE + 512 + (tid & 7) * 8 + ((tid >> 8) ? SI_IMG - 32 * SI_STRIDE : 0);
#define SA_LOAD(hp) do { const size_t pid_ = (size_t)pt[(hp) >> 1]; const float* cp_ = cckv + pid_ * 32768 + ((hp) & 1) * 16384; const float* kp_ = ckpe + pid_ * 4096 + ((hp) & 1) * 2048; \
        _Pragma("unroll") for (int i_ = 0; i_ < 8; ++i_) R[i_] = *(const GAS f32x4*)(cp_ + (size_t)(i_ * 512 + tid) * 4); \
        R[8] = *(const GAS f32x4*)(kp_ + (size_t)tid * 4); } while (0)
#define SA_STORE(buf) do { LAS unsigned char* ib_ = lds + (buf) * 2 * SI_IMG; \
        _Pragma("unroll") for (int i_ = 0; i_ < 8; ++i_) *(LAS u32x2*)(ib_ + (i_ >> 2) * SI_IMG + (i_ & 3) * 8 * SI_STRIDE + st_c) = (u32x2){pk2(R[i_].x, R[i_].y), pk2(R[i_].z, R[i_].w)}; \
        *(LAS u32x2*)(ib_ + st_k) = (u32x2){pk2(R[8].x, R[8].y), pk2(R[8].z, R[8].w)}; } while (0)
    float m_run = -INFINITY, l_run = 0.f; f32x16 oa[2];
#pragma unroll
    for (int cb = 0; cb < 2; ++cb)
#pragma unroll
        for (int r = 0; r < 16; ++r) oa[cb][r] = 0.f;
    SA_LOAD(0); SA_STORE(0); SA_LOAD(1);
    __syncthreads();
    const LAS unsigned char* qi = lds + SI_Q;
    for (int hp = 0; hp < NHP; ++hp) {
        const LAS unsigned char* img = lds + ((hp & 1) * 2 + im) * SI_IMG;
        f32x16 st;
#pragma unroll
        for (int r = 0; r < 16; ++r) st[r] = 0.f;
#pragma unroll 6
        for (int s = 0; s < 18; ++s) {
            const bf16x8 a = *(const LAS bf16x8*)(img + r32 * SI_STRIDE + 32 * s + 16 * hi);
            const bf16x8 q = *(const LAS bf16x8*)(qi + r32 * SI_STRIDE + 32 * s + 16 * hi);
            st = __builtin_amdgcn_mfma_f32_32x32x16_bf16(a, q, st, 0, 0, 0);
        }
        float mx = st[0];
#pragma unroll
        for (int r = 1; r < 16; ++r) mx = fmaxf(mx, st[r]);
        mx = fmaxf(mx, __shfl_xor(mx, 32));
        const float m_new = fmaxf(m_run, mx); const float alpha = __builtin_amdgcn_exp2f(m_run - m_new); m_run = m_new;
        float ps = 0.f;
#pragma unroll
        for (int r = 0; r < 16; ++r) { st[r] = __builtin_amdgcn_exp2f(st[r] - m_new); ps += st[r]; }
        l_run = l_run * alpha + ps;
        const bf16x8 pb0 = pack8(st, 0), pb1 = pack8(st, 8);
#pragma unroll
        for (int cb = 0; cb < 2; ++cb) {
#pragma unroll
            for (int r = 0; r < 16; ++r) oa[cb][r] *= alpha;
            const int c0 = (2 * qt + cb) * 32;
#pragma unroll
            for (int ks = 0; ks < 2; ++ks) {
                const LAS unsigned char* va = img + (16 * ks + 4 * hi + q4) * SI_STRIDE + (c0 + 16 * g1 + 4 * p4) * 2;
                const bf16x8 vf = join44(ldtr(va), ldtr(va + 8 * SI_STRIDE));
                oa[cb] = __builtin_amdgcn_mfma_f32_32x32x16_bf16(vf, ks == 0 ? pb0 : pb1, oa[cb], 0, 0, 0);
            }
        }
        if (hp + 1 < NHP) SA_STORE((hp + 1) & 1);
        if (hp + 2 < NHP) SA_LOAD(hp + 2);
        __syncthreads();
    }
#undef SA_LOAD
#undef SA_STORE
    float* rec = PART + ((size_t)(b * NSPLIT + sp) * 2 + im) * PART_F;
    const float lt = l_run + __shfl_xor(l_run, 32);
    if (qt == 0 && hi == 0) { rec[r32] = m_run; rec[32 + r32] = lt; }
#pragma unroll
    for (int cb = 0; cb < 2; ++cb)
#pragma unroll
        for (int r = 0; r < 16; ++r) rec[64 + ((2 * qt + cb) * 32 + crow(r, hi)) * 32 + r32] = oa[cb][r];
}
__device__ __forceinline__ void s_combine_unit(const float* PART, const bf16* QLAT, const bf16* CKVN, const bf16* KPEB, const float* w_uv, bf16* MIX, int b, LAS unsigned char* lds, int tid, int lane) {
    constexpr int NP = 2 * NSPLIT;
    LAS float* OL = (LAS float*)lds;
    LAS float* WP = OL + 32 * 257;
    LAS float* EJ = WP + NP * 32;
    LAS float* SN = EJ + 4 * 32;
    LAS float* KNW = SN + 32 * 4;
    const size_t mrow = (size_t)MP + (size_t)b * 4;
    for (int i = tid; i < 4 * 288; i += 512) { const int j = i / 288, c = i % 288; KNW[i] = c < 256 ? bf2f(CKVN[(mrow + j) * 256 + c]) : bf2f(KPEB[(mrow + j) * 32 + (c - 256)]); }
    __syncthreads();
    { const int q = tid >> 4, part = tid & 15; const bf16* ql = QLAT + (size_t)b * 32 * 288 + q * 288 + part * 18; float s[4] = {0.f, 0.f, 0.f, 0.f};
      for (int e = 0; e < 18; ++e) { const float qv = bf2f(ql[e]);
#pragma unroll
          for (int j = 0; j < 4; ++j) s[j] += qv * KNW[j * 288 + part * 18 + e]; }
#pragma unroll
      for (int j = 0; j < 4; ++j) { s[j] += __shfl_xor(s[j], 1); s[j] += __shfl_xor(s[j], 2); s[j] += __shfl_xor(s[j], 4); s[j] += __shfl_xor(s[j], 8); }
      if (part == 0) {
#pragma unroll
          for (int j = 0; j < 4; ++j) SN[q * 4 + j] = s[j]; } }
    __syncthreads();
    const float* rec0 = PART + (size_t)b * NP * PART_F;
    if (tid < 32) { const int q = tid, t = q & 3; float mg = -INFINITY; float mp[NP];
#pragma unroll
        for (int p = 0; p < NP; ++p) { mp[p] = rec0[(size_t)p * PART_F + q]; mg = fmaxf(mg, mp[p]); }
        for (int j = 0; j <= t; ++j) mg = fmaxf(mg, SN[q * 4 + j]);
        float L = 0.f; float wp[NP], ej[4];
#pragma unroll
        for (int p = 0; p < NP; ++p) { wp[p] = exp2f(mp[p] - mg); L += wp[p] * rec0[(size_t)p * PART_F + 32 + q]; }
#pragma unroll
        for (int j = 0; j < 4; ++j) { ej[j] = (j <= t) ? exp2f(SN[q * 4 + j] - mg) : 0.f; L += ej[j]; }
        const float iL = 1.0f / L;
#pragma unroll
        for (int p = 0; p < NP; ++p) WP[p * 32 + q] = wp[p] * iL;
#pragma unroll
        for (int j = 0; j < 4; ++j) EJ[j * 32 + q] = ej[j] * iL; }
    __syncthreads();
    { const int c = tid & 255, qh = tid >> 8; float acc[16];
#pragma unroll
      for (int i = 0; i < 16; ++i) acc[i] = 0.f;
      for (int p = 0; p < NP; ++p) { const float* op = rec0 + (size_t)p * PART_F + 64 + c * 32 + qh * 16;
#pragma unroll
          for (int v = 0; v < 4; ++v) { const f32x4 x = *(const GAS f32x4*)(op + 4 * v);
              acc[4 * v] += x.x * WP[p * 32 + qh * 16 + 4 * v]; acc[4 * v + 1] += x.y * WP[p * 32 + qh * 16 + 4 * v + 1]; acc[4 * v + 2] += x.z * WP[p * 32 + qh * 16 + 4 * v + 2]; acc[4 * v + 3] += x.w * WP[p * 32 + qh * 16 + 4 * v + 3]; } }
#pragma unroll
      for (int j = 0; j < 4; ++j) { const float kv = KNW[j * 288 + c];
#pragma unroll
          for (int i = 0; i < 16; ++i) acc[i] += kv * EJ[j * 32 + qh * 16 + i]; }
#pragma unroll
      for (int i = 0; i < 16; ++i) OL[(qh * 16 + i) * 257 + c] = acc[i]; }
    __syncthreads();
    { const int q = tid >> 4, dg = tid & 15, h = q >> 2, t = q & 3; f32x4 acc = (f32x4){0.f, 0.f, 0.f, 0.f};
      const float* w = w_uv + h * 64 + dg * 4;
#pragma unroll 8
      for (int c = 0; c < 256; ++c) { const f32x4 wv = *(const GAS f32x4*)(w + (size_t)c * 512); acc = acc + wv * OL[q * 257 + c]; }
      *(GAS u32x2*)(MIX + (mrow + t) * D + h * 64 + dg * 4) = (u32x2){pk2(acc.x, acc.y), pk2(acc.z, acc.w)}; }
    __syncthreads();
}
__device__ __forceinline__ void s_ret_unit(const bf16* RQ, const bf16* RK, const bf16* Z, const float* state0, const float* gng, const float* gnb, float* outRet, bf16* MIX, int b, int h, LAS unsigned char* lds, int tid, int wave, int lane) {
    LAS float* qv = (LAS float*)lds; LAS float* kv = qv + 512; LAS float* vv = kv + 512; LAS float* red = vv + 512;
    LAS float* qk = red + 2048; LAS float* ro = qk + 16; LAS float* prt = ro + 512;
    const size_t mrow = (size_t)MP + (size_t)b * 4; const float l2g = ret_log2g(h);
    { const int j = tid >> 7, d = tid & 127; qv[tid] = bf2f(RQ[(mrow + j) * 512 + h * 128 + d]); kv[tid] = bf2f(RK[(mrow + j) * 512 + h * 128 + d]); vv[tid] = bf2f(Z[(mrow + j) * DINP + ZRV + h * 128 + d]); }
    __syncthreads();
    if (tid < 16) { const int i = tid >> 2, j = tid & 3; float s = 0.f; for (int d = 0; d < 128; ++d) s += qv[i * 128 + d] * kv[j * 128 + d]; qk[tid] = s; }
    const int dv = tid & 127, qd = tid >> 7;
    const float* S0 = state0 + (size_t)(b * 4 + h) * 16384; float* S1 = outRet + (size_t)(b * 4 + h) * 16384;
    const float g4 = exp2f(l2g * 4.f), g3 = exp2f(l2g * 3.f), g2 = exp2f(l2g * 2.f), g1v = exp2f(l2g);
    const float v0 = vv[dv] * g3, v1 = vv[128 + dv] * g2, v2 = vv[256 + dv] * g1v, v3 = vv[384 + dv];
    float oacc[4] = {0.f, 0.f, 0.f, 0.f};
#pragma unroll 4
    for (int dk = qd * 32; dk < qd * 32 + 32; ++dk) { const float s0 = S0[dk * 128 + dv];
#pragma unroll
        for (int i = 0; i < 4; ++i) oacc[i] += qv[i * 128 + dk] * s0;
        S1[dk * 128 + dv] = g4 * s0 + kv[dk] * v0 + kv[128 + dk] * v1 + kv[256 + dk] * v2 + kv[384 + dk] * v3; }
#pragma unroll
    for (int i = 0; i < 4; ++i) red[(qd * 4 + i) * 128 + dv] = oacc[i];
    __syncthreads();
    { const int i = tid >> 7; float o = (red[(0 * 4 + i) * 128 + dv] + red[(1 * 4 + i) * 128 + dv]) + (red[(2 * 4 + i) * 128 + dv] + red[(3 * 4 + i) * 128 + dv]);
      o *= exp2f(l2g * (float)(i + 1));
      for (int j = 0; j <= i; ++j) o += exp2f(l2g * (float)(i - j)) * qk[i * 4 + j] * vv[j * 128 + dv];
      const float s = wave_sum(o); if (lane == 0) prt[wave] = s;
      __syncthreads();
      const float mean = (prt[2 * i] + prt[2 * i + 1]) * (1.f / 128.f); const float dd = o - mean;
      __syncthreads();
      const float s2 = wave_sum(dd * dd); if (lane == 0) prt[wave] = s2;
      __syncthreads();
      const float rstd = 1.0f / sqrtf((prt[2 * i] + prt[2 * i + 1]) * (1.f / 128.f) + LN_EPS);
      const float gate = bf2f(Z[(mrow + i) * DINP + ZRG + h * 128 + dv]);
      MIX[(mrow + i) * D + 512 + h * 128 + dv] = (bf16)f2bf((dd * rstd * gng[h * 128 + dv] + gnb[h * 128 + dv]) * pg8::silu_f(gate)); }
    __syncthreads();
}
__device__ __forceinline__ void pool_prep(const Args& A, const float* XF, bf16* POOLA, int gw, int NGW, int lane) {
    const float* spool = A.in[5];
    for (int m = gw; m < MT; m += NGW) {
        const bool prm = m < MP; const int t = prm ? (m & 8191) : ((m - MP) & 3); const int bs = prm ? 0 : ((m - MP) >> 2);
        const GAS f32x4* hrow = (const GAS f32x4*)(XF + (size_t)m * D) + lane;
        f32x4 hv[4];
#pragma unroll
        for (int j = 0; j < 4; ++j) hv[j] = hrow[64 * j];
#pragma unroll
        for (int j = 0; j < 4; ++j) { const int wl = 2 << j; f32x4 s = hv[j];
            for (int k = 1; k < wl; ++k) { const int tt = t - k;
                if (tt >= 0) s = s + ((const GAS f32x4*)(XF + (size_t)(m - k) * D) + lane)[64 * j];
                else if (!prm) s = s + ((const GAS f32x4*)(spool + ((size_t)bs * 15 + 15 + tt) * D) + lane)[64 * j]; }
            const float cnt = prm ? (float)((t + 1 < wl) ? t + 1 : wl) : (float)wl;
            const f32x4 o = s / cnt - hv[j];
            *(GAS unsigned long long*)(POOLA + ((size_t)j * MT + m) * 256 + 4 * lane) = (unsigned long long)pk2(o.x, o.y) | ((unsigned long long)pk2(o.z, o.w) << 32); }
        if (prm) { if (t >= TP - 15) { GAS f32x4* o = (GAS f32x4*)(A.out + OUT_POOLP + ((size_t)(m >> 13) * 15 + (t - (TP - 15))) * D) + lane;
#pragma unroll
                for (int j = 0; j < 4; ++j) o[64 * j] = hv[j]; } }
        else { GAS f32x4* o = (GAS f32x4*)(A.out + OUT_POOLS + ((size_t)bs * 15 + 11 + t) * D) + lane;
#pragma unroll
            for (int j = 0; j < 4; ++j) o[64 * j] = hv[j];
            if (t == 0) for (int i = 0; i < 11; ++i) { const GAS f32x4* src = (const GAS f32x4*)(spool + ((size_t)bs * 15 + i + 4) * D) + lane; GAS f32x4* dst = (GAS f32x4*)(A.out + OUT_POOLS + ((size_t)bs * 15 + i) * D) + lane;
#pragma unroll
                for (int j = 0; j < 4; ++j) dst[64 * j] = src[64 * j]; } }
    }
}
struct PoolOrder {
    int G, c;
    __device__ __forceinline__ bool next(int i, pg8::Unit& u) const { const long L = (long)i * G + c; if (L >= 4 * (MT / 256)) return false; const int g = (int)L / (MT / 256), pm = (int)L % (MT / 256); u.pm = g * (MT / 256) + pm; u.pn = g; return true; }
    __device__ __forceinline__ void a_ready(const pg8::Unit&) const {}
    __device__ __forceinline__ void done(const pg8::Unit&) const {}
};
struct EpiPoolF32 {
    static constexpr bool PERM = false, AFTER_DRAIN = false;
    float* C;
    __device__ __forceinline__ void operator()(const pg8::f32x4 (&acc)[2][2][4][2], const pg8::Unit& u, int wr, int wc, int fr, int fq) const {
        const int row0 = (u.pm % (MT / 256)) * 256 + wr * 64 + fr, col0 = u.pn * 256 + wc * 32 + 4 * fq;
#pragma unroll
        for (int ai = 0; ai < 2; ++ai)
#pragma unroll
            for (int m = 0; m < 4; ++m) { float* rowp = C + (size_t)(row0 + ai * 128 + m * 16) * D + col0;
#pragma unroll
                for (int bj = 0; bj < 2; ++bj)
#pragma unroll
                    for (int n = 0; n < 2; ++n) *(pg8::f32x4*)(rowp + bj * 128 + n * 16) = acc[ai][bj][m][n]; }
    }
};


#ifndef MK_PER_PHASE
#define MK_PER_PHASE 0
#endif
constexpr int N_STEPS = 24;
#ifndef MK_STEPS_RUN
#define MK_STEPS_RUN 24
#endif
#ifndef MK_SKIP
#define MK_SKIP 0
#endif
#define MK_ON(k) (((MK_SKIP >> (k)) & 1) == 0)
__global__ void __launch_bounds__(NWAVES * 64, 2) mk_fwd(Args args) {
    extern __shared__ __attribute__((aligned(16))) unsigned char lds_raw[];
    LAS unsigned char* lds = (LAS unsigned char*)lds_raw;
    volatile LAS unsigned* MISC = (volatile LAS unsigned*)(lds + MISC_OFF);
    const int G = gridDim.x, bx = blockIdx.x;
    const int vcu = (G % 8 == 0) ? (bx % 8) * (G / 8) + bx / 8 : bx;
    const int NGW = G * NWAVES;
    unsigned char* ws = args.ws;
    gu32* ctl = (gu32*)(ws + WS_CTL);
    for (int u = threadIdx.x; u < (LDS_BYTES - LDSCTL_OFF) / 4; u += NWAVES * 64) ((LAS unsigned*)(lds + LDSCTL_OFF))[u] = 0u;
    __syncthreads();
    XcdBarrier bar; bar.bar = (unsigned*)(ctl + CW_BAR); bar.x = 0; bar.st = nullptr;
    if (!MK_PER_PHASE) bar = xcd_barrier_post((unsigned*)(ctl + CW_BAR), MISC + 8);
    const int lo = args.ph_lo, hi = args.ph_hi;
    int step = 0;
#define STEP_IF if (lo <= step && step < hi)
#define FRESH_TID int tid_f = threadIdx.x; asm volatile("" : "+v"(tid_f)); const int tid = tid_f, lane = tid & 63, wave = __builtin_amdgcn_readfirstlane(tid >> 6), gw = vcu * NWAVES + wave; (void)lane; (void)gw
#define STEP_END do { if (lo <= step && step + 1 < hi) { xcd_barrier(bar); } ++step; } while (0)

    bf16* XB = (bf16*)(ws + WS_XB); float* XF = (float*)(ws + WS_XF); float* Y = (float*)(ws + WS_Y); bf16* HFF = (bf16*)(ws + WS_HFF);
    bf16* Z = (bf16*)(ws + WS_Z); bf16* MIX = (bf16*)(ws + WS_MIX);
    const float* ln_gain = args.in[10]; const float* ln_bias = args.in[11];

    STEP_IF if (MK_ON(0)) { FRESH_TID; p0_prologue(args, lds, gw, NGW, wave, lane); }
    STEP_END;

#pragma unroll
    for (int f = 0; f < 4; ++f) {
        const int layer = f >> 1, mm = f & 1;
        STEP_IF if (MK_ON(1)) { FRESH_TID; pg8::Gemm g{XB, (const bf16*)(ws + WS_WGU) + (size_t)f * NGU * D, MT, NGU, D}; pg8::StaticOrder S; S.init(MT, NGU, G, bx);
            pg8::EpiSwiGLU E{HFF, DFF};
            pg8::gemm_phase<pg8::EpiSwiGLU, pg8::StaticOrder, true, true>(lds + RING_OFF, g, S, E); }
        STEP_END;
        STEP_IF if (MK_ON(2)) { FRESH_TID; pg8::Gemm g{HFF, (const bf16*)(ws + WS_WD) + (size_t)f * D * DFF, MT, D, DFF}; pg8::StaticOrder S; S.init(MT, D, G, bx);
            pg8::EpiF32 E{Y, D};
            pg8::gemm_phase<pg8::EpiF32, pg8::StaticOrder, true, true>(lds + RING_OFF, g, S, E); }
        STEP_END;
        STEP_IF if (MK_ON(3)) { FRESH_TID; ln_phase(args, f == 0 ? nullptr : XF, Y, 0.5f, nullptr, nullptr, ln_gain + (layer * 3 + 2 * mm) * D, ln_bias + (layer * 3 + 2 * mm) * D, f == 3 ? args.out : XF, XB, gw, NGW, lane); }
        STEP_END;

        if (f == 0) {
            STEP_IF if (MK_ON(4)) { FRESH_TID; pg8::Gemm g{XB, (const bf16*)(ws + WS_WIN), MT, DINP, D}; pg8::StaticOrder S; S.init(MT, DINP, G, bx);
                pg8::EpiBf16P E{Z, DINP};
                pg8::gemm_phase<pg8::EpiBf16P, pg8::StaticOrder, true, true>(lds + RING_OFF, g, S, E); }
            STEP_END;
            STEP_IF if (MK_ON(5)) { FRESH_TID; post_phase(args, gw, NGW, lane); }
            STEP_END;
            STEP_IF if (MK_ON(6)) { FRESH_TID;
                { pg8::Gemm g{(const bf16*)(ws + WS_QLN), (const bf16*)(ws + WS_WUQ), MT, 768, 512}; pg8::StaticOrder S; S.init(MT, 768, G, bx);
                  pg8::EpiQ E{(bf16*)(ws + WS_Q), (const float2*)(ws + WS_ROPE32), QSCALE};
                  pg8::gemm_phase<pg8::EpiQ, pg8::StaticOrder, true, true>(lds + RING_OFF, g, S, E); }
                __syncthreads();
                { pg8::Gemm g{(const bf16*)(ws + WS_CKVN), (const bf16*)(ws + WS_WUKT), MP, 512, 256}; pg8::StaticOrder S; S.init(MP, 512, G, (bx + G - 198 % G) % G);
                  pg8::EpiBf16P E{(bf16*)(ws + WS_KN), 512};
                  pg8::gemm_phase<pg8::EpiBf16P, pg8::StaticOrder, true, true>(lds + RING_OFF, g, S, E); }
                __syncthreads();
                { pg8::Gemm g{(const bf16*)(ws + WS_WUVT), (const bf16*)(ws + WS_CKVN), 512, MP, 256}; pg8::StaticOrder S; S.init(512, MP, G, (bx + G - 70 % G) % G);
                  pg8::EpiBf16P E{(bf16*)(ws + WS_VT), MP};
                  pg8::gemm_phase<pg8::EpiBf16P, pg8::StaticOrder, true, true>(lds + RING_OFF, g, S, E); }
                __syncthreads();
                for (int u = vcu; u < 512; u += G) ret_a_unit((const bf16*)(ws + WS_RK), Z, (float*)(ws + WS_KVC), u >> 6, u & 63, lds, tid, wave, lane);
            }
            STEP_END;
            STEP_IF if (MK_ON(7)) { FRESH_TID;
                ret_scan((const float*)(ws + WS_KVC), (bf16*)(ws + WS_SST), args.out + OUT_RETP, vcu * 512 + tid, G * 512);
                for (int u = vcu; u < NBS; u += G) s_absorb_unit((const bf16*)(ws + WS_Q), args.in[16], (bf16*)(ws + WS_QLAT), u, lds, tid);
                for (int u = vcu; u < 256; u += G) { const int bh = u >> 4, s = u & 15;
                    attn_unit_prompt((const bf16*)(ws + WS_Q), (const bf16*)(ws + WS_KN), (const bf16*)(ws + WS_KPEB), (const bf16*)(ws + WS_VT), MIX, bh >> 3, bh & 7, s, lds, tid, wave, lane);
                    attn_unit_prompt((const bf16*)(ws + WS_Q), (const bf16*)(ws + WS_KN), (const bf16*)(ws + WS_KPEB), (const bf16*)(ws + WS_VT), MIX, bh >> 3, bh & 7, 31 - s, lds, tid, wave, lane); }
            }
            STEP_END;
            STEP_IF if (MK_ON(8)) { FRESH_TID;
                for (int u = vcu; u < NBS * NSPLIT; u += G) s_attn_unit(args.in[2], args.in[3], (const int*)args.in[6], (const bf16*)(ws + WS_QLAT), (float*)(ws + WS_PART), u / NSPLIT, u % NSPLIT, lds, tid, wave, lane);
                __syncthreads();
                for (int u = vcu; u < 512; u += G) ret_c_unit((const bf16*)(ws + WS_RQ), (const bf16*)(ws + WS_RK), Z, (const bf16*)(ws + WS_SST), args.in[18], args.in[19], MIX, u >> 6, u & 63, lds, tid, wave, lane);
                for (int u = vcu; u < NBS * 4; u += G) s_ret_unit((const bf16*)(ws + WS_RQ), (const bf16*)(ws + WS_RK), Z, args.in[4], args.in[18], args.in[19], args.out + OUT_RETS, MIX, u >> 2, u & 3, lds, tid, wave, lane);
            }
            STEP_END;
            STEP_IF if (MK_ON(9)) { FRESH_TID; for (int u = vcu; u < NBS; u += G) s_combine_unit((const float*)(ws + WS_PART), (const bf16*)(ws + WS_QLAT), (const bf16*)(ws + WS_CKVN), (const bf16*)(ws + WS_KPEB), args.in[17], MIX, u, lds, tid, lane); }
            STEP_END;
            STEP_IF if (MK_ON(10)) { FRESH_TID; pg8::Gemm g{MIX, (const bf16*)(ws + WS_WOUT), MT, D, D}; pg8::StaticOrder S; S.init(MT, D, G, bx);
                pg8::EpiF32 E{Y, D};
                pg8::gemm_phase<pg8::EpiF32, pg8::StaticOrder, true, true>(lds + RING_OFF, g, S, E); }
            STEP_END;
            STEP_IF if (MK_ON(11)) { FRESH_TID; ln_phase(args, XF, Y, 1.0f, nullptr, nullptr, ln_gain + (0 * 3 + 1) * D, ln_bias + (0 * 3 + 1) * D, XF, XB, gw, NGW, lane); }
            STEP_END;
        }
        if (f == 2) {
            STEP_IF if (MK_ON(12)) { FRESH_TID; pool_prep(args, XF, (bf16*)(ws + WS_POOLA), gw, NGW, lane); }
            STEP_END;
            STEP_IF if (MK_ON(13)) { FRESH_TID; pg8::Gemm g{(const bf16*)(ws + WS_POOLA), (const bf16*)(ws + WS_WPOOL), 4 * MT, D, 256}; PoolOrder S{G, bx};
                EpiPoolF32 E{Y};
                pg8::gemm_phase<EpiPoolF32, PoolOrder, true, true>(lds + RING_OFF, g, S, E); }
            STEP_END;
            STEP_IF if (MK_ON(14)) { FRESH_TID; ln_phase(args, XF, Y, 1.0f, args.in[22], args.in[23], ln_gain + (1 * 3 + 1) * D, ln_bias + (1 * 3 + 1) * D, XF, XB, gw, NGW, lane); }
            STEP_END;
        }
    }
#undef STEP_IF
#undef STEP_END
}


#ifdef MK_SANITIZE
__global__ void __launch_bounds__(256) mk_sanitize(float* out, size_t n) {
    for (size_t i = (size_t)blockIdx.x * 256 + threadIdx.x; i < n; i += (size_t)gridDim.x * 256) { const float v = out[i]; if (!(fabsf(v) < 3.0e38f)) out[i] = 0.f; }
}
#endif
extern "C" void kernel_launch(void* const* d_in, const int* in_sizes, int n_in, void* d_out, int out_size, void* d_ws, size_t ws_size, hipStream_t stream) {
    static int grid = 0;
    if (grid == 0) {
        if (n_in != 24 || (size_t)out_size != OUT_TOTAL || ws_size < WS_END) { fprintf(stderr, "kernel_launch: unexpected shapes: n_in %d out %d ws %zu\n", n_in, out_size, ws_size); grid = -1; return; }
        int dev = 0, cus = 0, per_cu = 0;
        if (hipGetDevice(&dev) != hipSuccess || hipDeviceGetAttribute(&cus, hipDeviceAttributeMultiprocessorCount, dev) != hipSuccess) { grid = -1; return; }
        if (hipFuncSetAttribute((const void*)mk_fwd, hipFuncAttributeMaxDynamicSharedMemorySize, LDS_BYTES) != hipSuccess) { fprintf(stderr, "kernel_launch: hipFuncSetAttribute failed\n"); grid = -1; return; }
        if (hipOccupancyMaxActiveBlocksPerMultiprocessor(&per_cu, (const void*)mk_fwd, NWAVES * 64, LDS_BYTES) != hipSuccess || per_cu < 1)
            fprintf(stderr, "kernel_launch: note: occupancy query reports %d workgroups per CU\n", per_cu);
        (void)hipGetLastError();
        grid = cus;
    }
    if (grid < 0) return;
    if (hipMemsetAsync((char*)d_ws + WS_CTL, 0, CTL_ZERO_BYTES, stream) != hipSuccess) return;
#if MK_STEPS_RUN < N_STEPS
    (void)hipMemsetAsync(d_out, 0, (size_t)out_size * 4, stream);
#endif
    Args a{};
    for (int i = 0; i < 24; ++i) a.in[i] = (const float*)d_in[i];
    a.out = (float*)d_out; a.ws = (unsigned char*)d_ws;
#if MK_PER_PHASE
    for (int s = 0; s < MK_STEPS_RUN; ++s) { a.ph_lo = s; a.ph_hi = s + 1; hipLaunchKernelGGL(mk_fwd, dim3(grid), dim3(NWAVES * 64), LDS_BYTES, stream, a); }
#else
    a.ph_lo = 0; a.ph_hi = N_STEPS;
    hipLaunchKernelGGL(mk_fwd, dim3(grid), dim3(NWAVES * 64), LDS_BYTES, stream, a);
#endif
#ifdef MK_SANITIZE
    hipLaunchKernelGGL(mk_sanitize, dim3(2048), dim3(256), 0, stream, (float*)d_out, (size_t)out_size);
#endif
    const hipError_t le = hipPeekAtLastError();
    if (le != hipSuccess) fprintf(stderr, "kernel_launch: launch failed: %s\n", hipGetErrorName(le));
}
```

```cpp
#include <hip/hip_runtime.h>
#include <cstdio>
#include <cstdint>
#include <cmath>
namespace pg8 {
#define PG8_LAS __attribute__((address_space(3)))
typedef unsigned short bf16_t;
typedef short bf16x8 __attribute__((ext_vector_type(8)));
typedef float f32x4 __attribute__((ext_vector_type(4)));
typedef unsigned u32x4 __attribute__((ext_vector_type(4)));
constexpr int BM = 256, BK = 64, HALF = 128, HTB = HALF * BK * 2  , STAGE_BYTES = 8 * HTB, NXCD = 8, WGM = 8;

__host__ __device__ __forceinline__ int lds_byte(int r, int c) { const int st = (r >> 4) * 2 + (c >> 5), rr = r & 15, cc = c & 31, ob = rr * 64 + cc * 2; return st * 1024 + (ob ^ (((ob >> 9) & 1) << 5)); }
__host__ __device__ __forceinline__ void stage_rc(int b, int& R, int& C) { const int st = b / 1024, sb = b % 1024, swz = sb ^ (((sb >> 9) & 1) << 5); R = (st >> 1) * 16 + swz / 64; C = (st & 1) * 32 + (swz % 64) / 2; }
__host__ __device__ __forceinline__ int perm32(int rho) { const int n = rho >> 4, i = rho & 15; return 8 * (i >> 2) + 4 * n + (i & 3); }

struct Unit { int pm, pn; };
struct Gemm { const bf16_t* A; const bf16_t* Bt; int M, N, K; };

struct StaticOrder {
    int nM, nN, nwg, G, c;
    __host__ __device__ void init(int M, int N, int G_, int c_) { nM = M / BM; nN = N / BM; nwg = nM * nN; G = G_; c = c_; }
    __host__ __device__ bool next(int i, Unit& u) const {
        const long L = (long)i * G + c; if (L >= nwg) return false;
        int wgid = (int)L; { const int q = nwg / NXCD, r = nwg % NXCD, xcd = wgid % NXCD, off = wgid / NXCD; wgid = (xcd < r ? xcd * (q + 1) : r * (q + 1) + (xcd - r) * q) + off; }
        const int nig = WGM * nN, gid = wgid / nig, fm = gid * WGM, gsz = (nM - fm) < WGM ? (nM - fm) : WGM;
        u.pm = fm + ((wgid % nig) % gsz); u.pn = (wgid % nig) / gsz; return true;
    }
    __device__ __forceinline__ void a_ready(const Unit&) const {}
    __device__ __forceinline__ void done(const Unit&) const {}
};

typedef float f32x2_t __attribute__((ext_vector_type(2))); typedef __bf16 bf16x2_t __attribute__((ext_vector_type(2)));
__device__ __forceinline__ unsigned cvt_pk_bf16(float lo, float hi) { f32x2_t v = {lo, hi}; bf16x2_t b = __builtin_convertvector(v, bf16x2_t); return __builtin_bit_cast(unsigned, b); }
typedef float f32x2 __attribute__((ext_vector_type(2)));
__device__ __forceinline__ int row_pos(int r) { return r < 16384 ? (r & 8191) : 8192 + ((r - 16384) & 3); }
struct EpiF32 {
    static constexpr bool PERM = false, AFTER_DRAIN = false;
    float* C; int ldc;
    __device__ __forceinline__ void operator()(const f32x4 (&acc)[2][2][4][2], const Unit& u, int wr, int wc, int fr, int fq) const {
        const int row0 = u.pm * BM + wr * 64 + fr, col0 = u.pn * BM + wc * 32 + 4 * fq;
#pragma unroll
        for (int ai = 0; ai < 2; ++ai)
#pragma unroll
            for (int m = 0; m < 4; ++m) { float* rowp = C + (size_t)(row0 + ai * HALF + m * 16) * ldc + col0;
#pragma unroll
                for (int bj = 0; bj < 2; ++bj)
#pragma unroll
                    for (int n = 0; n < 2; ++n) *(f32x4*)(rowp + bj * HALF + n * 16) = acc[ai][bj][m][n]; }
    }
};
struct EpiBf16P {
    static constexpr bool PERM = true, AFTER_DRAIN = false;
    bf16_t* O; int ldc;
    __device__ __forceinline__ void operator()(const f32x4 (&acc)[2][2][4][2], const Unit& u, int wr, int wc, int fr, int fq) const {
        const int row0 = u.pm * BM + wr * 64 + fr, col0 = u.pn * BM + wc * 32 + 8 * fq;
#pragma unroll
        for (int ai = 0; ai < 2; ++ai)
#pragma unroll
            for (int m = 0; m < 4; ++m) { bf16_t* rowp = O + (size_t)(row0 + ai * HALF + m * 16) * ldc + col0;
#pragma unroll
                for (int bj = 0; bj < 2; ++bj) { const f32x4 v0 = acc[ai][bj][m][0], v1 = acc[ai][bj][m][1];
                    u32x4 w; w.x = cvt_pk_bf16(v0[0], v0[1]); w.y = cvt_pk_bf16(v0[2], v0[3]); w.z = cvt_pk_bf16(v1[0], v1[1]); w.w = cvt_pk_bf16(v1[2], v1[3]);
                    *(u32x4*)(rowp + bj * HALF) = w; } }
    }
};
__device__ __forceinline__ float silu_f(float g) { return g * __builtin_amdgcn_rcpf(1.0f + __builtin_amdgcn_exp2f(-1.4426950408889634f * g)); }
struct EpiSwiGLU {
    static constexpr bool PERM = true, AFTER_DRAIN = false;
    bf16_t* O; int ldc;
    __device__ __forceinline__ void operator()(const f32x4 (&acc)[2][2][4][2], const Unit& u, int wr, int wc, int fr, int fq) const {
        const int row0 = u.pm * BM + wr * 64 + fr, col0 = u.pn * HALF + wc * 32 + 8 * fq;
#pragma unroll
        for (int ai = 0; ai < 2; ++ai)
#pragma unroll
            for (int m = 0; m < 4; ++m) { bf16_t* rowp = O + (size_t)(row0 + ai * HALF + m * 16) * ldc + col0;
                const f32x4 g0 = acc[ai][0][m][0], g1 = acc[ai][0][m][1], u0 = acc[ai][1][m][0], u1 = acc[ai][1][m][1];
                u32x4 w;
                w.x = cvt_pk_bf16(silu_f(g0[0]) * u0[0], silu_f(g0[1]) * u0[1]); w.y = cvt_pk_bf16(silu_f(g0[2]) * u0[2], silu_f(g0[3]) * u0[3]);
                w.z = cvt_pk_bf16(silu_f(g1[0]) * u1[0], silu_f(g1[1]) * u1[1]); w.w = cvt_pk_bf16(silu_f(g1[2]) * u1[2], silu_f(g1[3]) * u1[3]);
                *(u32x4*)rowp = w; }
    }
};
struct EpiQ {
    static constexpr bool PERM = true, AFTER_DRAIN = false;
    bf16_t* O; const float2* rope32; float sc;
    __device__ __forceinline__ void operator()(const f32x4 (&acc)[2][2][4][2], const Unit& u, int wr, int wc, int fr, int fq) const {
        const int row0 = u.pm * BM + wr * 64 + fr, col0 = u.pn * BM + wc * 32 + 8 * fq;
#pragma unroll
        for (int ai = 0; ai < 2; ++ai)
#pragma unroll
            for (int m = 0; m < 4; ++m) { const int r = row0 + ai * HALF + m * 16; bf16_t* rowp = O + (size_t)r * 768 + col0;
                const float2* rt = rope32 + (size_t)row_pos(r) * 16 + 8 * (fq & 1);
#pragma unroll
                for (int bj = 0; bj < 2; ++bj) { f32x4 v0 = acc[ai][bj][m][0], v1 = acc[ai][bj][m][1];
                    const int grp = u.pn * 8 + bj * 4 + wc;
                    if (grp % 3 == 2) {
                        float x[8] = {v0[0], v0[1], v0[2], v0[3], v1[0], v1[1], v1[2], v1[3]};
#pragma unroll
                        for (int e = 0; e < 8; ++e) { const float other = __shfl_xor(x[e], 32); const float2 cs = rt[e];
                            x[e] = (fq < 2) ? (x[e] * cs.x - other * cs.y) : (other * cs.y + x[e] * cs.x); }
                        v0 = (f32x4){x[0], x[1], x[2], x[3]}; v1 = (f32x4){x[4], x[5], x[6], x[7]};
                    }
                    v0 = v0 * sc; v1 = v1 * sc;
                    u32x4 w; w.x = cvt_pk_bf16(v0[0], v0[1]); w.y = cvt_pk_bf16(v0[2], v0[3]); w.z = cvt_pk_bf16(v1[0], v1[1]); w.w = cvt_pk_bf16(v1[2], v1[3]);
                    *(u32x4*)(rowp + bj * HALF) = w; } }
    }
};
template <class Epi, class Sched, bool ALIGN_EPI = false, bool SP2 = false>
__device__ __forceinline__ void gemm_phase(PG8_LAS unsigned char* lds, const Gemm g, const Sched& S, const Epi& E) {
    int tid_ = threadIdx.x; asm volatile("" : "+v"(tid_));
    const int tid = tid_, wid = __builtin_amdgcn_readfirstlane(tid >> 6), lane = tid & 63, wr = wid >> 2, wc = wid & 3, fr = lane & 15, fq = lane >> 4;
    int K_ = g.K; asm volatile("" : "+s"(K_));
    const int K = K_, nt = K / BK;
    unsigned voffA[2], voffB[2];
#pragma unroll
    for (int i = 0; i < 2; ++i) { int R, C; stage_rc(tid * 16 + i * 8192, R, C); const int Rb = Epi::PERM ? ((R & ~31) + perm32(R & 31)) : R;
        voffA[i] = (unsigned)(R * K + C) * 2u; voffB[i] = (unsigned)(Rb * K + C) * 2u; }
    const size_t kstep = (size_t)(BK * 2);
    const size_t hstep = (size_t)HALF * K * 2;
    const size_t tstep = 2 * hstep;
    const unsigned ldsw = (unsigned)wid * 1024u;
    const int aoff = lds_byte(wr * 64 + fr, fq * 8), boff = lds_byte(wc * 32 + fr, fq * 8);
#define PG8_SA(b, h) (((b) * 2 + (h)) * HTB)
#define PG8_SB(b, h) ((4 + (b) * 2 + (h)) * HTB)
#define PG8_STAGE(bufoff, gbase, voff) do { _Pragma("unroll") for (int _i = 0; _i < 2; ++_i) \
        __builtin_amdgcn_global_load_lds((const unsigned*)((const char*)(gbase) + (voff)[_i]), (PG8_LAS unsigned*)(lds + (bufoff) + ldsw + _i * 8192), 16, 0, 0); } while (0)
#define PG8_LDA(dst, b, h) do { _Pragma("unroll") for (int m = 0; m < 4; ++m) _Pragma("unroll") for (int k = 0; k < 2; ++k) dst[m][k] = *(const PG8_LAS bf16x8*)(lds + PG8_SA(b, h) + aoff + m * 2048 + k * 1024); } while (0)
#define PG8_LDB(dst, b, h) do { _Pragma("unroll") for (int n = 0; n < 2; ++n) _Pragma("unroll") for (int k = 0; k < 2; ++k) dst[n][k] = *(const PG8_LAS bf16x8*)(lds + PG8_SB(b, h) + boff + n * 2048 + k * 1024); } while (0)
#define PG8_MMA(ai, bj, At, Bt) do { __builtin_amdgcn_s_setprio(1); _Pragma("unroll") for (int m = 0; m < 4; ++m) _Pragma("unroll") for (int n = 0; n < 2; ++n) _Pragma("unroll") for (int k = 0; k < 2; ++k) \
        acc[ai][bj][m][n] = __builtin_amdgcn_mfma_f32_16x16x32_bf16(Bt[n][k], At[m][k], acc[ai][bj][m][n], 0, 0, 0); __builtin_amdgcn_s_setprio(0); } while (0)
#define PG8_WAIT_V(n) asm volatile("s_waitcnt vmcnt(" #n ")" ::: "memory")
#define PG8_WAIT_L(n) asm volatile("s_waitcnt lgkmcnt(" #n ")" ::: "memory")
#define PG8_BAR __builtin_amdgcn_s_barrier()
#define PG8_SCHED __builtin_amdgcn_sched_barrier(0)
    Unit cur, nxt; int ui = 0;
    if (!S.next(0, cur)) return;
    f32x4 acc[2][2][4][2];
#pragma unroll
    for (int a = 0; a < 2; ++a)
#pragma unroll
        for (int b = 0; b < 2; ++b)
#pragma unroll
            for (int m = 0; m < 4; ++m)
#pragma unroll
                for (int n = 0; n < 2; ++n) acc[a][b][m][n] = (f32x4){0.f, 0.f, 0.f, 0.f};
    bf16x8 At[4][2], B0[2][2], B1[2][2];
    const char* cA = (const char*)g.A + (size_t)cur.pm * tstep; const char* cB = (const char*)g.Bt + (size_t)cur.pn * tstep;
    S.a_ready(cur);
    if constexpr (SP2) {
        PG8_STAGE(PG8_SB(0, 0), cB, voffB); PG8_STAGE(PG8_SB(0, 1), cB + hstep, voffB); PG8_STAGE(PG8_SA(0, 0), cA, voffA); PG8_STAGE(PG8_SA(0, 1), cA + hstep, voffA);
        if (wr == 1) PG8_BAR;
        PG8_WAIT_V(2); PG8_BAR;
        PG8_STAGE(PG8_SB(1, 0), cB + kstep, voffB); PG8_STAGE(PG8_SA(1, 0), cA + kstep, voffA); PG8_STAGE(PG8_SB(1, 1), cB + hstep + kstep, voffB);
        PG8_WAIT_V(6); PG8_BAR;
    } else {
        PG8_STAGE(PG8_SB(0, 0), cB, voffB); PG8_STAGE(PG8_SA(0, 0), cA, voffA); PG8_STAGE(PG8_SB(0, 1), cB + hstep, voffB); PG8_STAGE(PG8_SA(0, 1), cA + hstep, voffA);
        if (wr == 1) PG8_BAR;
        PG8_WAIT_V(4); PG8_BAR;
        PG8_STAGE(PG8_SB(1, 0), cB + kstep, voffB); PG8_STAGE(PG8_SA(1, 0), cA + kstep, voffA); PG8_STAGE(PG8_SB(1, 1), cB + hstep + kstep, voffB);
        PG8_WAIT_V(6); PG8_BAR;
    }
    for (;;) {
        const bool has_next = S.next(ui + 1, nxt);
        const char* nA = has_next ? (const char*)g.A + (size_t)nxt.pm * tstep : cA; const char* nB = has_next ? (const char*)g.Bt + (size_t)nxt.pn * tstep : cB;
        for (int t = 0; t < nt; t += 2) {
            const bool last = (t == nt - 2);
            const char* a1 = cA + (size_t)(t + 1) * kstep;
            const char* a2 = last ? nA : cA + (size_t)(t + 2) * kstep; const char* b2 = last ? nB : cB + (size_t)(t + 2) * kstep;
            const char* a3 = a2 + kstep; const char* b3 = b2 + kstep;
            if (last && has_next) S.a_ready(nxt);
            if constexpr (SP2) {
            PG8_LDB(B0, 0, 0); PG8_LDB(B1, 0, 1); PG8_SCHED; PG8_LDA(At, 0, 0); PG8_STAGE(PG8_SA(1, 1), a1 + hstep, voffA);
            PG8_WAIT_V(8); PG8_WAIT_L(0); PG8_BAR; PG8_MMA(0, 0, At, B0); PG8_MMA(0, 1, At, B1); PG8_BAR; PG8_SCHED;
            PG8_LDA(At, 0, 1); PG8_STAGE(PG8_SB(0, 0), b2, voffB); PG8_STAGE(PG8_SB(0, 1), b2 + hstep, voffB); PG8_STAGE(PG8_SA(0, 0), a2, voffA);
            PG8_WAIT_V(8); PG8_WAIT_L(0); PG8_BAR; PG8_MMA(1, 0, At, B0); PG8_MMA(1, 1, At, B1); PG8_BAR; PG8_SCHED;
            PG8_LDB(B0, 1, 0); PG8_LDB(B1, 1, 1); PG8_SCHED; PG8_LDA(At, 1, 0); PG8_STAGE(PG8_SA(0, 1), a2 + hstep, voffA);
            PG8_WAIT_V(8); PG8_WAIT_L(0); PG8_BAR; PG8_MMA(0, 0, At, B0); PG8_MMA(0, 1, At, B1); PG8_BAR; PG8_SCHED;
            PG8_LDA(At, 1, 1); PG8_STAGE(PG8_SB(1, 0), b3, voffB); PG8_STAGE(PG8_SB(1, 1), b3 + hstep, voffB); PG8_STAGE(PG8_SA(1, 0), a3, voffA);
            PG8_WAIT_V(8); PG8_WAIT_L(0); PG8_BAR; PG8_MMA(1, 0, At, B0); PG8_MMA(1, 1, At, B1); PG8_BAR; PG8_SCHED;
            } else {
            PG8_LDB(B0, 0, 0); PG8_SCHED; PG8_LDA(At, 0, 0); PG8_STAGE(PG8_SA(1, 1), a1 + hstep, voffA);
            PG8_WAIT_L(8); PG8_BAR; PG8_WAIT_L(0); PG8_MMA(0, 0, At, B0); PG8_BAR; PG8_SCHED;
            PG8_LDB(B1, 0, 1); PG8_STAGE(PG8_SB(0, 0), b2, voffB);
            PG8_BAR; PG8_WAIT_L(0); PG8_MMA(0, 1, At, B1); PG8_BAR;
            PG8_LDA(At, 0, 1); PG8_STAGE(PG8_SA(0, 0), a2, voffA);
            PG8_BAR; PG8_WAIT_L(0); PG8_MMA(1, 0, At, B0); PG8_BAR; PG8_SCHED;
            PG8_STAGE(PG8_SB(0, 1), b2 + hstep, voffB);
            PG8_WAIT_V(6); PG8_BAR; PG8_MMA(1, 1, At, B1); PG8_BAR;
            PG8_LDB(B0, 1, 0); PG8_SCHED; PG8_LDA(At, 1, 0); PG8_STAGE(PG8_SA(0, 1), a2 + hstep, voffA);
            PG8_WAIT_L(8); PG8_BAR; PG8_WAIT_L(0); PG8_MMA(0, 0, At, B0); PG8_BAR; PG8_SCHED;
            PG8_LDB(B1, 1, 1); PG8_STAGE(PG8_SB(1, 0), b3, voffB);
            PG8_BAR; PG8_WAIT_L(0); PG8_MMA(0, 1, At, B1); PG8_BAR;
            PG8_LDA(At, 1, 1); PG8_STAGE(PG8_SA(1, 0), a3, voffA);
            PG8_BAR; PG8_WAIT_L(0); PG8_MMA(1, 0, At, B0); PG8_BAR; PG8_SCHED;
            PG8_STAGE(PG8_SB(1, 1), b3 + hstep, voffB);
            PG8_WAIT_V(6); PG8_BAR; PG8_MMA(1, 1, At, B1); PG8_BAR;
            }
        }
        if constexpr (ALIGN_EPI) { if (wr == 0) PG8_BAR; }
        if constexpr (!Epi::AFTER_DRAIN) { E(acc, cur, wr, wc, fr, fq); S.done(cur); }
        if (!has_next) break;
#pragma unroll
        for (int a = 0; a < 2; ++a)
#pragma unroll
            for (int b = 0; b < 2; ++b)
#pragma unroll
                for (int m = 0; m < 4; ++m)
#pragma unroll
                    for (int n = 0; n < 2; ++n) acc[a][b][m][n] = (f32x4){0.f, 0.f, 0.f, 0.f};
        cur = nxt; cA = nA; cB = nB; ++ui;
        if constexpr (ALIGN_EPI) { if (wr == 1) PG8_BAR; }
    }
    PG8_WAIT_V(0);
    if constexpr (!ALIGN_EPI) { if (wr == 0) PG8_BAR; }
    PG8_BAR;
    if constexpr (Epi::AFTER_DRAIN) { E.fused(acc, cur, wr, wc, fr, fq, lds, wid, lane); S.done(cur); }
#undef PG8_SA
#undef PG8_SB
#undef PG8_STAGE
#undef PG8_LDA
#undef PG8_LDB
#undef PG8_MMA
#undef PG8_WAIT_V
#undef PG8_WAIT_L
#undef PG8_BAR
#undef PG8_SCHED
}
}
#define GAS __attribute__((address_space(1)))
#define LAS __attribute__((address_space(3)))
typedef unsigned short bf16;
typedef unsigned v4u __attribute__((ext_vector_type(4)));
typedef float f32x4 __attribute__((ext_vector_type(4)));
typedef short bf16x8 __attribute__((ext_vector_type(8)));
typedef GAS unsigned gu32;
typedef GAS unsigned long long gu64;
#define RLX_AGENT __ATOMIC_RELAXED, __HIP_MEMORY_SCOPE_AGENT
#define LDS_WAIT() asm volatile("s_waitcnt lgkmcnt(0)" ::: "memory")
#define VM_WAIT() asm volatile("s_waitcnt vmcnt(0)" ::: "memory")
__device__ __forceinline__ unsigned long long rt() { return __builtin_amdgcn_s_memrealtime(); }
__device__ __forceinline__ unsigned f2bf(float f) { unsigned u = __builtin_bit_cast(unsigned, f); return (u + 0x7fffu + ((u >> 16) & 1u)) >> 16; }
__device__ __forceinline__ unsigned pk2(float lo, float hi) { return f2bf(lo) | (f2bf(hi) << 16); }

#define XB_TMO      128
#define XB_XCNT(j)  (256  + 64 * (j))
#define XB_XSUB(j)  (1280 + 64 * (j))
#define XB_XGEN(j)  (2304 + 64 * (j))
#define XB_TOP      3328
#define XB_TOPGEN   3392
#define XCD_BAR_WORDS 3456
#define XB_SPIN_CAP (1u << 18)

__device__ __forceinline__ unsigned xb_ld(unsigned* p)              { return __hip_atomic_load(p, __ATOMIC_RELAXED, __HIP_MEMORY_SCOPE_AGENT); }
__device__ __forceinline__ unsigned xb_add(unsigned* p, unsigned v) { return __hip_atomic_fetch_add(p, v, __ATOMIC_RELAXED, __HIP_MEMORY_SCOPE_AGENT); }
__device__ __forceinline__ unsigned xb_xcc_id() { return (unsigned)__builtin_amdgcn_s_getreg((3 << 11) | 20) & 0xFu; }
#define XB_SPIN(cond, bar) do { unsigned _sp = 0; while (cond) { __builtin_amdgcn_s_sleep(1); \
    if ((++_sp & 255u) == 0u) { if (xb_ld(&(bar)[XB_TMO])) break; if (_sp > XB_SPIN_CAP) { atomicAdd(&(bar)[XB_TMO], 1u); break; } } } } while (0)

struct XcdBarrier {
    unsigned* bar; unsigned x;
    volatile LAS unsigned* st;
};

__device__ __forceinline__ XcdBarrier xcd_barrier_post(unsigned* bar, volatile LAS unsigned* st) {
    XcdBarrier b; b.bar = bar; b.x = xb_xcc_id(); b.st = st;
    if (threadIdx.x == 0) (void)xb_add(&bar[XB_XCNT(b.x)], 1u);
    return b;
}
__device__ __forceinline__ void xcd_barrier_complete(unsigned* bar, unsigned x, unsigned& nloc, unsigned& nx) {
    const unsigned G = gridDim.x * gridDim.y * gridDim.z;
    unsigned sum, cnt, mine, sp = 0u;
    for (;;) {
        sum = 0u; cnt = 0u; mine = 0u;
#pragma unroll
        for (unsigned j = 0; j < 16; ++j) { const unsigned c = xb_ld(&bar[XB_XCNT(j)]); sum += c; cnt += (c > 0u) ? 1u : 0u; mine = (j == x) ? c : mine; }
        if (sum == G) break;
        __builtin_amdgcn_s_sleep(1);
        if ((++sp & 255u) == 0u) { if (xb_ld(&bar[XB_TMO])) break; if (sp > XB_SPIN_CAP) { atomicAdd(&bar[XB_TMO], 1u); break; } }
    }
    nloc = mine > 0u ? mine : 1u; nx = cnt > 0u ? cnt : 1u;
}

__device__ __forceinline__ void xcd_barrier(const XcdBarrier& b) {
    asm volatile("s_waitcnt vmcnt(0)" ::: "memory");
    __syncthreads();
    if (threadIdx.x == 0) {
        unsigned* bar = b.bar;
        __builtin_amdgcn_s_waitcnt(0);
        unsigned nloc = b.st[0], nx = b.st[1];
        if (nloc == 0u) { xcd_barrier_complete(bar, b.x, nloc, nx); b.st[0] = nloc; b.st[1] = nx; }
        const unsigned old = xb_add(&bar[XB_XSUB(b.x)], 1u);
        const unsigned gen = old / nloc;
        if (old + 1u == (gen + 1u) * nloc) {
            __builtin_amdgcn_fence(__ATOMIC_RELEASE, "agent");
            asm volatile("s_waitcnt vmcnt(0)" ::: "memory");
            const unsigned og = xb_add(&bar[XB_TOP], 1u);
            const unsigned tg = og / nx;
            if (og + 1u == (tg + 1u) * nx) xb_add(&bar[XB_TOPGEN], 1u);
            else XB_SPIN(xb_ld(&bar[XB_TOPGEN]) == tg, bar);
            __builtin_amdgcn_fence(__ATOMIC_ACQUIRE, "agent");
            xb_add(&bar[XB_XGEN(b.x)], 1u);
            asm volatile("s_waitcnt vmcnt(0)" ::: "memory");
        } else {
            XB_SPIN(xb_ld(&bar[XB_XGEN(b.x)]) == gen, bar);
            __builtin_amdgcn_fence(__ATOMIC_ACQUIRE, "agent");
            asm volatile("s_waitcnt vmcnt(0)" ::: "memory");
        }
    }
    __syncthreads();
}
constexpr int NWAVES = 8;
constexpr int D = 1024, TP = 8192, MP = 16384, NBS = 128, TS = 4, MS = 512, MT = MP + MS;
constexpr int DFF = 2816, NGU = 2 * DFF, DIN = 2848, DINP = 3072;
constexpr int ZQ = 0, ZCKV = 512, ZKPE = 768, ZRQ = 800, ZRK = 1312, ZRV = 1824, ZRG = 2336;
constexpr int NPOS = 8196;
constexpr float ALPHA = 1.4142135623730951f;
constexpr float LN_EPS = 1e-5f, RMS_EPS = 1e-6f;
constexpr float QSCALE = 0.10206207261596575f * 1.4426950408889634f;
constexpr int NSPLIT = 2;
constexpr int PART_F = 64 + 8192;
constexpr size_t OUT_YP = 0, OUT_YS = 16777216, OUT_CKVP = 17301504, OUT_KPEP = 21495808, OUT_CKVS = 22020096, OUT_KPES = 22151168,
                 OUT_RETP = 22167552, OUT_RETS = 22298624, OUT_POOLP = 30687232, OUT_POOLS = 30717952, OUT_TOTAL = 32684032;
constexpr size_t MiB = 1u << 20;
constexpr size_t WS_CTL = 0, CTL_ZERO_BYTES = 1 * MiB;
constexpr size_t WS_ROPE32 = 1 * MiB;
constexpr size_t WS_ROPE128 = WS_ROPE32 + 2 * MiB;
constexpr size_t WS_WGU = WS_ROPE128 + 5 * MiB;
constexpr size_t WS_WD = WS_WGU + 44 * MiB;
constexpr size_t WS_WIN = WS_WD + 22 * MiB;
constexpr size_t WS_WUQ = WS_WIN + 6 * MiB;
constexpr size_t WS_WUKT = WS_WUQ + 1 * MiB;
constexpr size_t WS_WUVT = WS_WUKT + 262144;
constexpr size_t WS_WOUT = WS_WUKT + 1 * MiB;
constexpr size_t WS_WPOOL = WS_WOUT + 2 * MiB;
constexpr size_t WS_XB = WS_WPOOL + 1 * MiB;
constexpr size_t WS_XF = WS_XB + 33 * MiB;
constexpr size_t WS_Y = WS_XF + 66 * MiB;
constexpr size_t WS_HFF = WS_Y + 66 * MiB;
constexpr size_t WS_Z = WS_HFF + 91 * MiB;
constexpr size_t WS_QLN = WS_Z + 99 * MiB;
constexpr size_t WS_CKVN = WS_QLN + 17 * MiB;
constexpr size_t WS_KPEB = WS_CKVN + 9 * MiB;
constexpr size_t WS_RQ = WS_KPEB + 2 * MiB;
constexpr size_t WS_RK = WS_RQ + 17 * MiB;
constexpr size_t WS_Q = WS_RK + 17 * MiB;
constexpr size_t WS_KN = WS_Q + 25 * MiB;
constexpr size_t WS_VT = WS_KN + 16 * MiB;
constexpr size_t WS_MIX = WS_VT + 16 * MiB;
constexpr size_t WS_KVC = WS_MIX + 33 * MiB;
constexpr size_t WS_SST = WS_KVC + 32 * MiB;
constexpr size_t WS_QLAT = WS_SST + 16 * MiB;
constexpr size_t WS_PART = WS_QLAT + 3 * MiB;
constexpr size_t WS_POOLA = WS_PART + 34 * MiB;
constexpr size_t WS_END = WS_POOLA + 33 * MiB;
static_assert((size_t)NBS * NSPLIT * 4 * PART_F * 4 <= 34 * MiB, "PART region");
constexpr int CW_TMO = 0, CW_CODE = 1, CW_BAR = 4096;
constexpr int RING_OFF = 0, RING_BYTES = 131072;
constexpr int LDSCTL_OFF = 155648, MISC_OFF = LDSCTL_OFF + 320;
constexpr int LDS_BYTES = 157696;
static_assert(MISC_OFF + 128 <= LDS_BYTES, "LDS map");

__device__ __forceinline__ float wave_sum(float v) {
#pragma unroll
    for (int o = 1; o < 64; o <<= 1) v += __shfl_xor(v, o);
    return v;
}
__device__ __forceinline__ float bf2f(unsigned short b) { return __uint_as_float((unsigned)b << 16); }
__device__ __forceinline__ float bflo(unsigned w) { return __uint_as_float(w << 16); }
__device__ __forceinline__ float bfhi(unsigned w) { return __uint_as_float(w & 0xffff0000u); }

__device__ __forceinline__ void transpose_item(const float* W, int ldw, bf16* WT, int ldt, int k0, int n0, int drow0, LAS float* scr, int lane) {
#pragma unroll 8
    for (int i = 0; i < 32; ++i) { const int kk = 2 * i + (lane >> 5); scr[kk * 33 + (lane & 31)] = W[(size_t)(k0 + kk) * ldw + n0 + (lane & 31)]; }
    LDS_WAIT(); asm volatile("" ::: "memory");
    const int c = lane & 7;
#pragma unroll
    for (int j = 0; j < 4; ++j) { const int n = (lane >> 3) + 8 * j; const LAS float* s = scr + (8 * c) * 33 + n;
        v4u o; o.x = pk2(s[0 * 33], s[1 * 33]); o.y = pk2(s[2 * 33], s[3 * 33]); o.z = pk2(s[4 * 33], s[5 * 33]); o.w = pk2(s[6 * 33], s[7 * 33]);
        *(GAS v4u*)(WT + (size_t)(drow0 + n) * ldt + k0 + 8 * c) = o; }
    LDS_WAIT(); asm volatile("" ::: "memory");
}

struct Args { const float* in[24]; float* out; unsigned char* ws; int ph_lo, ph_hi; };

__device__ __forceinline__ void p0_prologue(const Args& A, LAS unsigned char* lds, int gw, int NGW, int wave, int lane) {
    unsigned char* ws = A.ws;
    LAS float* scr = (LAS float*)(lds + wave * 16384);
    bf16* WGU = (bf16*)(ws + WS_WGU); bf16* WD = (bf16*)(ws + WS_WD); bf16* WIN = (bf16*)(ws + WS_WIN); bf16* WUQ = (bf16*)(ws + WS_WUQ);
    bf16* WUKT = (bf16*)(ws + WS_WUKT); bf16* WUVT = (bf16*)(ws + WS_WUVT); bf16* WOUT = (bf16*)(ws + WS_WOUT); bf16* WPOOL = (bf16*)(ws + WS_WPOOL);
    constexpr int I_GU = 4 * 2 * 16 * 88, I_D = 4 * 44 * 32, I_IN = 16 * 89, I_UQ = 8 * 24, I_UK = 4 * 16, I_OUT = 16 * 32, I_POOL = 4 * 4 * 8;
    constexpr int NITEMS = I_GU + I_D + I_IN + I_UQ + 2 * I_UK + I_OUT + I_POOL;
    for (int it = gw; it < NITEMS; it += NGW) {
        int r = it;
        if (r < I_GU) { const int lm = r / 2816; r -= lm * 2816; const int up = r / 1408; r -= up * 1408; const int kb = r / 88, n0 = (r % 88) * 32;
            transpose_item((up ? A.in[8] : A.in[7]) + (size_t)lm * D * DFF, DFF, WGU + (size_t)lm * NGU * D, D, kb * 64, n0, (n0 / 128) * 256 + (n0 % 128) + up * 128, scr, lane); continue; }
        r -= I_GU;
        if (r < I_D) { const int lm = r / 1408; r -= lm * 1408; const int kb = r / 32, n0 = (r % 32) * 32;
            transpose_item(A.in[9] + (size_t)lm * DFF * D, D, WD + (size_t)lm * D * DFF, DFF, kb * 64, n0, n0, scr, lane); continue; }
        r -= I_D;
        if (r < I_IN) { const int kb = r / 89, n0 = (r % 89) * 32; transpose_item(A.in[12], DIN, WIN, D, kb * 64, n0, n0, scr, lane); continue; }
        r -= I_IN;
        if (r < I_UQ) { const int kb = r / 24, n0 = (r % 24) * 32; transpose_item(A.in[15], 768, WUQ, 512, kb * 64, n0, n0, scr, lane); continue; }
        r -= I_UQ;
        if (r < I_UK) { const int kb = r / 16, n0 = (r % 16) * 32; transpose_item(A.in[16], 512, WUKT, 256, kb * 64, n0, n0, scr, lane); continue; }
        r -= I_UK;
        if (r < I_UK) { const int kb = r / 16, n0 = (r % 16) * 32; transpose_item(A.in[17], 512, WUVT, 256, kb * 64, n0, n0, scr, lane); continue; }
        r -= I_UK;
        if (r < I_OUT) { const int kb = r / 32, n0 = (r % 32) * 32; transpose_item(A.in[20], D, WOUT, D, kb * 64, n0, n0, scr, lane); continue; }
        r -= I_OUT;
        { const int g = r / 32; r -= g * 32; const int kb = r / 8, n0 = (r % 8) * 32; transpose_item(A.in[21] + (size_t)g * 65536, 256, WPOOL + (size_t)g * 65536, 256, kb * 64, n0, n0, scr, lane); }
    }
    { GAS v4u* z = (GAS v4u*)(WIN + (size_t)DIN * D); const int n16 = (DINP - DIN) * D * 2 / 16;
      for (int i = gw * 64 + lane; i < n16; i += NGW * 64) z[i] = (v4u){0u, 0u, 0u, 0u}; }
    { bf16* XB = (bf16*)(ws + WS_XB);
      for (int m = gw; m < MT; m += NGW) { const float* xr = (m < MP) ? A.in[0] + (size_t)m * D : A.in[1] + (size_t)(m - MP) * D;
          const GAS f32x4* x4 = (const GAS f32x4*)xr + lane; GAS unsigned long long* o8 = (GAS unsigned long long*)(XB + (size_t)m * D) + lane;
#pragma unroll
          for (int j = 0; j < 4; ++j) { const f32x4 v = x4[64 * j]; o8[64 * j] = (unsigned long long)pk2(v.x, v.y) | ((unsigned long long)pk2(v.z, v.w) << 32); } } }
    { float2* R32 = (float2*)(ws + WS_ROPE32); float2* R128 = (float2*)(ws + WS_ROPE128);
      for (int i = gw * 64 + lane; i < NPOS * 80; i += NGW * 64) { const int pos = i / 80, k = i % 80;
          const bool small = k < 16; const int idx = small ? k : k - 16; const float rr = small ? 32.f : 128.f;
          const float inv = 1.0f / powf(10000.0f, (float)(2 * idx) / rr); const float ang = (float)pos * inv;
          const float2 cs = make_float2(cosf(ang), sinf(ang));
          if (small) R32[pos * 16 + idx] = cs; else R128[pos * 64 + idx] = cs; } }
}

__device__ __forceinline__ void ln_phase(const Args& A, const float* hres, const float* Y, float ysc, const float* cb, const float* cs, const float* gain, const float* bias, float* outF, bf16* outB, int gw, int NGW, int lane) {
    const GAS f32x4* g4 = (const GAS f32x4*)gain + lane; const GAS f32x4* b4 = (const GAS f32x4*)bias + lane;
    f32x4 g[4], b[4];
#pragma unroll
    for (int j = 0; j < 4; ++j) { g[j] = g4[64 * j]; b[j] = b4[64 * j]; }
    f32x4 cbv[4], csv[4];
#pragma unroll
    for (int j = 0; j < 4; ++j) { cbv[j] = cb ? ((const GAS f32x4*)cb + lane)[64 * j] : (f32x4){0.f, 0.f, 0.f, 0.f}; csv[j] = cs ? ((const GAS f32x4*)cs + lane)[64 * j] * ysc : (f32x4){ysc, ysc, ysc, ysc}; }
    for (int m = gw; m < MT; m += NGW) {
        const float* hr = hres ? hres + (size_t)m * D : ((m < MP) ? A.in[0] + (size_t)m * D : A.in[1] + (size_t)(m - MP) * D);
        const GAS f32x4* h4 = (const GAS f32x4*)hr + lane; const GAS f32x4* y4 = (const GAS f32x4*)(Y + (size_t)m * D) + lane;
        f32x4 v[4]; float s = 0.f;
#pragma unroll
        for (int j = 0; j < 4; ++j) { v[j] = h4[64 * j] * ALPHA + (y4[64 * j] + cbv[j]) * csv[j]; s += (v[j].x + v[j].y) + (v[j].z + v[j].w); }
        const float mean = wave_sum(s) * (1.f / D); float s2 = 0.f;
#pragma unroll
        for (int j = 0; j < 4; ++j) { v[j] = v[j] - mean; s2 += (v[j].x * v[j].x + v[j].y * v[j].y) + (v[j].z * v[j].z + v[j].w * v[j].w); }
        const float rstd = 1.f / sqrtf(wave_sum(s2) * (1.f / D) + LN_EPS);
        GAS f32x4* o4 = (GAS f32x4*)(outF + (size_t)m * D) + lane; GAS unsigned long long* o8 = (GAS unsigned long long*)(outB + (size_t)m * D) + lane;
#pragma unroll
        for (int j = 0; j < 4; ++j) { const f32x4 o = v[j] * rstd * g[j] + b[j]; o4[64 * j] = o;
            o8[64 * j] = (unsigned long long)pk2(o.x, o.y) | ((unsigned long long)pk2(o.z, o.w) << 32); }
    }
}

__device__ __forceinline__ void post_phase(const Args& A, int gw, int NGW, int lane) {
    unsigned char* ws = A.ws;
    const bf16* Z = (const bf16*)(ws + WS_Z); bf16* QLN = (bf16*)(ws + WS_QLN); bf16* CKVN = (bf16*)(ws + WS_CKVN); bf16* KPEB = (bf16*)(ws + WS_KPEB);
    bf16* RQ = (bf16*)(ws + WS_RQ); bf16* RK = (bf16*)(ws + WS_RK);
    const float2* R32 = (const float2*)(ws + WS_ROPE32); const float2* R128 = (const float2*)(ws + WS_ROPE128);
    const float* qg = A.in[13]; const float* kg = A.in[14];
    for (int m = gw; m < MT; m += NGW) {
        const bf16* z = Z + (size_t)m * DINP; const int pos = pg8::row_pos(m);
        { const v4u w = *(const GAS v4u*)(z + ZQ + 8 * lane);
          float x[8] = {bflo(w.x), bfhi(w.x), bflo(w.y), bfhi(w.y), bflo(w.z), bfhi(w.z), bflo(w.w), bfhi(w.w)};
          float s = 0.f;
#pragma unroll
          for (int e = 0; e < 8; ++e) s += x[e] * x[e];
          const float r = 1.0f / sqrtf(wave_sum(s) * (1.f / 512.f) + RMS_EPS);
          const f32x4 g0 = *(const GAS f32x4*)(qg + 8 * lane), g1 = *(const GAS f32x4*)(qg + 8 * lane + 4);
          v4u o; o.x = pk2(x[0] * r * g0.x, x[1] * r * g0.y); o.y = pk2(x[2] * r * g0.z, x[3] * r * g0.w); o.z = pk2(x[4] * r * g1.x, x[5] * r * g1.y); o.w = pk2(x[6] * r * g1.z, x[7] * r * g1.w);
          *(GAS v4u*)(QLN + (size_t)m * 512 + 8 * lane) = o; }
        { const unsigned long long w = *(const GAS unsigned long long*)(z + ZCKV + 4 * lane); const unsigned w0 = (unsigned)w, w1 = (unsigned)(w >> 32);
          float x[4] = {bflo(w0), bfhi(w0), bflo(w1), bfhi(w1)};
          const float s = (x[0] * x[0] + x[1] * x[1]) + (x[2] * x[2] + x[3] * x[3]);
          const float r = 1.0f / sqrtf(wave_sum(s) * (1.f / 256.f) + RMS_EPS);
          const f32x4 g0 = *(const GAS f32x4*)(kg + 4 * lane);
          const f32x4 o = (f32x4){x[0] * r * g0.x, x[1] * r * g0.y, x[2] * r * g0.z, x[3] * r * g0.w};
          float* outp = A.out + ((m < MP) ? OUT_CKVP + (size_t)m * 256 : OUT_CKVS + (size_t)(m - MP) * 256);
          *(GAS f32x4*)(outp + 4 * lane) = o;
          *(GAS unsigned long long*)(CKVN + (size_t)m * 256 + 4 * lane) = (unsigned long long)pk2(o.x, o.y) | ((unsigned long long)pk2(o.z, o.w) << 32); }
        if (lane < 16) { const float x1 = bf2f(z[ZKPE + lane]), x2 = bf2f(z[ZKPE + 16 + lane]); const float2 cs = R32[pos * 16 + lane];
          const float o1 = x1 * cs.x - x2 * cs.y, o2 = x1 * cs.y + x2 * cs.x;
          float* outp = A.out + ((m < MP) ? OUT_KPEP + (size_t)m * 32 : OUT_KPES + (size_t)(m - MP) * 32);
          outp[lane] = o1; outp[16 + lane] = o2; KPEB[(size_t)m * 32 + lane] = (bf16)f2bf(o1); KPEB[(size_t)m * 32 + 16 + lane] = (bf16)f2bf(o2); }
        { const int tk = lane >> 5, hh = (lane >> 3) & 3, c8 = lane & 7; const bf16* src = z + (tk ? ZRK : ZRQ) + hh * 128 + 8 * c8;
          const v4u a = *(const GAS v4u*)src, bq = *(const GAS v4u*)(src + 64);
          const GAS f32x4* cs4 = (const GAS f32x4*)(R128 + pos * 64 + 8 * c8);
          const float x1[8] = {bflo(a.x), bfhi(a.x), bflo(a.y), bfhi(a.y), bflo(a.z), bfhi(a.z), bflo(a.w), bfhi(a.w)};
          const float x2[8] = {bflo(bq.x), bfhi(bq.x), bflo(bq.y), bfhi(bq.y), bflo(bq.z), bfhi(bq.z), bflo(bq.w), bfhi(bq.w)};
          const float ks = tk ? 0.08838834764831845f : 1.0f; float o1[8], o2[8];
#pragma unroll
          for (int e2 = 0; e2 < 4; ++e2) { const f32x4 cs = cs4[e2];
              o1[2 * e2] = (x1[2 * e2] * cs.x - x2[2 * e2] * cs.y) * ks; o2[2 * e2] = (x1[2 * e2] * cs.y + x2[2 * e2] * cs.x) * ks;
              o1[2 * e2 + 1] = (x1[2 * e2 + 1] * cs.z - x2[2 * e2 + 1] * cs.w) * ks; o2[2 * e2 + 1] = (x1[2 * e2 + 1] * cs.w + x2[2 * e2 + 1] * cs.z) * ks; }
          bf16* dst = (tk ? RK : RQ) + (size_t)m * 512 + hh * 128 + 8 * c8;
          *(GAS v4u*)dst = (v4u){pk2(o1[0], o1[1]), pk2(o1[2], o1[3]), pk2(o1[4], o1[5]), pk2(o1[6], o1[7])};
          *(GAS v4u*)(dst + 64) = (v4u){pk2(o2[0], o2[1]), pk2(o2[2], o2[3]), pk2(o2[4], o2[5]), pk2(o2[6], o2[7])}; }
    }
}
typedef float f32x16 __attribute__((ext_vector_type(16)));
typedef short s16x4 __attribute__((ext_vector_type(4)));
typedef unsigned u32x2 __attribute__((ext_vector_type(2)));
__device__ __forceinline__ int crow(int r, int hi) { return (r & 3) + 8 * (r >> 2) + 4 * hi; }
__device__ __forceinline__ unsigned cvtpk(float lo, float hi) { return pg8::cvt_pk_bf16(lo, hi); }
__device__ __forceinline__ bf16x8 pack8(const f32x16& p, int b) {
    v4u w; w.x = cvtpk(p[b], p[b + 1]); w.y = cvtpk(p[b + 2], p[b + 3]); w.z = cvtpk(p[b + 4], p[b + 5]); w.w = cvtpk(p[b + 6], p[b + 7]);
    return __builtin_bit_cast(bf16x8, w);
}
__device__ __forceinline__ bf16x8 join44(s16x4 a, s16x4 b) { return (bf16x8){a[0], a[1], a[2], a[3], b[0], b[1], b[2], b[3]}; }
typedef short v4i16_t __attribute__((ext_vector_type(4)));
__device__ __forceinline__ s16x4 ldtr(const LAS unsigned char* p) { return __builtin_bit_cast(s16x4, __builtin_amdgcn_ds_read_tr16_b64_v4i16((LAS v4i16_t*)p)); }

constexpr int AK_STRIDE = 208, AV_STRIDE = 136, AK_BYTES = 64 * AK_STRIDE, AV_BYTES = 64 * AV_STRIDE;
__device__ __forceinline__ void attn_unit_prompt(const bf16* Q, const bf16* KN, const bf16* KPEB, const bf16* VT, bf16* MIX, int b, int h, int qb, LAS unsigned char* lds, int tid, int wave, int lane) {
    const int r32 = lane & 31, hi = lane >> 5;
    const int qloc = qb * 256 + wave * 32 + r32;
    const size_t qrow = (size_t)b * TP + qloc;
    bf16x8 qr[6];
#pragma unroll
    for (int s = 0; s < 6; ++s) qr[s] = *(const GAS bf16x8*)(Q + qrow * 768 + h * 96 + 16 * s + 8 * hi);
    const int NT = 4 * (qb + 1);
    const int kc0 = tid, kc1 = tid + 512; const bool k1v = kc1 < 768;
    const int kr0 = kc0 / 12, kh0 = kc0 % 12, kr1 = k1v ? kc1 / 12 : 0, kh1 = k1v ? kc1 % 12 : 0;
    const int vr = tid >> 3, vh = tid & 7;
    const bf16* kbase = KN + (size_t)b * TP * 512 + h * 64; const bf16* pbase = KPEB + (size_t)b * TP * 32; const bf16* vbase = VT + (size_t)(h * 64 + vr) * MP + (size_t)b * TP + vh * 8;
    v4u gk0, gk1, gv;
#define ATT_LOAD(t) do { const int t0_ = (t) * 64; \
        gk0 = (kh0 < 8) ? *(const GAS v4u*)(kbase + (size_t)(t0_ + kr0) * 512 + kh0 * 8) : *(const GAS v4u*)(pbase + (size_t)(t0_ + kr0) * 32 + (kh0 - 8) * 8); \
        if (k1v) gk1 = (kh1 < 8) ? *(const GAS v4u*)(kbase + (size_t)(t0_ + kr1) * 512 + kh1 * 8) : *(const GAS v4u*)(pbase + (size_t)(t0_ + kr1) * 32 + (kh1 - 8) * 8); \
        gv = *(const GAS v4u*)(vbase + t0_); } while (0)
#define ATT_STORE(buf) do { LAS unsigned char* kb_ = lds + (buf) * AK_BYTES; LAS unsigned char* vb_ = lds + 2 * AK_BYTES + (buf) * AV_BYTES; \
        *(LAS v4u*)(kb_ + kr0 * AK_STRIDE + kh0 * 16) = gk0; if (k1v) *(LAS v4u*)(kb_ + kr1 * AK_STRIDE + kh1 * 16) = gk1; \
        *(LAS u32x2*)(vb_ + vr * AV_STRIDE + vh * 16) = (u32x2){gv.x, gv.y}; *(LAS u32x2*)(vb_ + vr * AV_STRIDE + vh * 16 + 8) = (u32x2){gv.z, gv.w}; } while (0)
    float m_run = -INFINITY, l_run = 0.f; f32x16 o0, o1;
#pragma unroll
    for (int r = 0; r < 16; ++r) { o0[r] = 0.f; o1[r] = 0.f; }
    ATT_LOAD(0); ATT_STORE(0); __syncthreads();
    const int qmaxw = qb * 256 + wave * 32 + 31;
    for (int t = 0; t < NT; ++t) {
        const bool more = (t + 1 < NT);
        if (more) ATT_LOAD(t + 1);
        if (64 * t <= qmaxw) {
            const LAS unsigned char* kb = lds + (t & 1) * AK_BYTES; const LAS unsigned char* vb = lds + 2 * AK_BYTES + (t & 1) * AV_BYTES;
            f32x16 p0, p1;
#pragma unroll
            for (int r = 0; r < 16; ++r) { p0[r] = 0.f; p1[r] = 0.f; }
#pragma unroll
            for (int s = 0; s < 6; ++s) {
                const bf16x8 a0 = *(const LAS bf16x8*)(kb + r32 * AK_STRIDE + 32 * s + 16 * hi);
                const bf16x8 a1 = *(const LAS bf16x8*)(kb + (32 + r32) * AK_STRIDE + 32 * s + 16 * hi);
                p0 = __builtin_amdgcn_mfma_f32_32x32x16_bf16(a0, qr[s], p0, 0, 0, 0);
                p1 = __builtin_amdgcn_mfma_f32_32x32x16_bf16(a1, qr[s], p1, 0, 0, 0);
            }
            if (64 * t + 63 > qb * 256 + wave * 32) {
#pragma unroll
                for (int r = 0; r < 16; ++r) { const int kv = 64 * t + crow(r, hi); if (kv > qloc) p0[r] = -INFINITY; if (kv + 32 > qloc) p1[r] = -INFINITY; }
            }
            float mx = fmaxf(p0[0], p1[0]);
#pragma unroll
            for (int r = 1; r < 16; ++r) mx = fmaxf(mx, fmaxf(p0[r], p1[r]));
            mx = fmaxf(mx, __shfl_xor(mx, 32));
            const float m_new = fmaxf(m_run, mx); const float alpha = __builtin_amdgcn_exp2f(m_run - m_new); m_run = m_new;
            float ps = 0.f;
#pragma unroll
            for (int r = 0; r < 16; ++r) { p0[r] = __builtin_amdgcn_exp2f(p0[r] - m_new); p1[r] = __builtin_amdgcn_exp2f(p1[r] - m_new); ps += p0[r] + p1[r]; }
            l_run = l_run * alpha + ps;
#pragma unroll
            for (int r = 0; r < 16; ++r) { o0[r] *= alpha; o1[r] *= alpha; }
            const bf16x8 pb0 = pack8(p0, 0), pb1 = pack8(p0, 8), pb2 = pack8(p1, 0), pb3 = pack8(p1, 8);
#pragma unroll
            for (int ks = 0; ks < 4; ++ks) {
                const bf16x8 pb = ks == 0 ? pb0 : ks == 1 ? pb1 : ks == 2 ? pb2 : pb3;
                const LAS unsigned char* va = vb + r32 * AV_STRIDE + (16 * ks + 4 * hi) * 2;
                const bf16x8 v0 = join44(*(const LAS s16x4*)(va), *(const LAS s16x4*)(va + 16));
                const bf16x8 v1 = join44(*(const LAS s16x4*)(va + 32 * AV_STRIDE), *(const LAS s16x4*)(va + 32 * AV_STRIDE + 16));
                o0 = __builtin_amdgcn_mfma_f32_32x32x16_bf16(v0, pb, o0, 0, 0, 0);
                o1 = __builtin_amdgcn_mfma_f32_32x32x16_bf16(v1, pb, o1, 0, 0, 0);
            }
        }
        if (more) ATT_STORE((t + 1) & 1);
        __syncthreads();
    }
#undef ATT_LOAD
#undef ATT_STORE
    const float lt = l_run + __shfl_xor(l_run, 32); const float il = 1.0f / lt;
    bf16* orow = MIX + qrow * D + h * 64;
#pragma unroll
    for (int g = 0; g < 4; ++g) {
        *(GAS u32x2*)(orow + 8 * g + 4 * hi) = (u32x2){pk2(o0[4 * g] * il, o0[4 * g + 1] * il), pk2(o0[4 * g + 2] * il, o0[4 * g + 3] * il)};
        *(GAS u32x2*)(orow + 32 + 8 * g + 4 * hi) = (u32x2){pk2(o1[4 * g] * il, o1[4 * g + 1] * il), pk2(o1[4 * g + 2] * il, o1[4 * g + 3] * il)};
    }
}

__device__ __forceinline__ float ret_log2g(int h) { return log2f(1.0f - exp2f(-5.0f - (float)h)); }
constexpr int RS_TR = 320, RS_ROW = 272;
__device__ __forceinline__ void ret_a_unit(const bf16* RK, const bf16* Z, float* KVC, int bh, int c, LAS unsigned char* lds, int tid, int wave, int lane) {
    const int b = bh >> 2, h = bh & 3; const size_t row0 = (size_t)b * TP + (size_t)c * 128; const float l2g = ret_log2g(h);
    LAS unsigned char* KT = lds; LAS unsigned char* VTl = lds + 128 * RS_TR;
#pragma unroll
    for (int i = 0; i < 4; ++i) { const int cid = tid + 512 * i, j = cid >> 4, ch = cid & 15;
        const v4u kk = *(const GAS v4u*)(RK + (row0 + j) * 512 + h * 128 + ch * 8);
        *(LAS v4u*)(KT + j * RS_TR + ch * 16) = kk;
        const v4u vv = *(const GAS v4u*)(Z + (row0 + j) * DINP + ZRV + h * 128 + ch * 8);
        const float sc = exp2f(l2g * (float)(127 - j));
        v4u o; o.x = pk2(bflo(vv.x) * sc, bfhi(vv.x) * sc); o.y = pk2(bflo(vv.y) * sc, bfhi(vv.y) * sc); o.z = pk2(bflo(vv.z) * sc, bfhi(vv.z) * sc); o.w = pk2(bflo(vv.w) * sc, bfhi(vv.w) * sc);
        *(LAS v4u*)(VTl + j * RS_TR + ch * 16) = o; }
    __syncthreads();
    const int r32 = lane & 31, hi = lane >> 5, g1 = (lane >> 4) & 1, q4 = (lane & 15) >> 2, p4 = lane & 3;
    const int mb = wave >> 1, nb0 = (wave & 1) * 2;
    f32x16 a0, a1;
#pragma unroll
    for (int r = 0; r < 16; ++r) { a0[r] = 0.f; a1[r] = 0.f; }
    const int laneoff = (8 * hi + q4) * RS_TR + (16 * g1 + 4 * p4) * 2;
#pragma unroll
    for (int s = 0; s < 8; ++s) {
        const LAS unsigned char* ka = KT + laneoff + s * 16 * RS_TR + mb * 64;
        const bf16x8 af = join44(ldtr(ka), ldtr(ka + 4 * RS_TR));
        const LAS unsigned char* va = VTl + laneoff + s * 16 * RS_TR + nb0 * 64;
        const bf16x8 b0 = join44(ldtr(va), ldtr(va + 4 * RS_TR));
        const bf16x8 b1 = join44(ldtr(va + 64), ldtr(va + 64 + 4 * RS_TR));
        a0 = __builtin_amdgcn_mfma_f32_32x32x16_bf16(af, b0, a0, 0, 0, 0);
        a1 = __builtin_amdgcn_mfma_f32_32x32x16_bf16(af, b1, a1, 0, 0, 0);
    }
    float* outp = KVC + ((size_t)bh * 64 + c) * 16384;
#pragma unroll
    for (int r = 0; r < 16; ++r) { const int dk = mb * 32 + crow(r, hi);
        outp[dk * 128 + nb0 * 32 + r32] = a0[r]; outp[dk * 128 + (nb0 + 1) * 32 + r32] = a1[r]; }
    __syncthreads();
}
__device__ __forceinline__ void ret_scan(const float* KVC, bf16* SST, float* outRet, int gtid, int gthreads) {
    for (int e = gtid; e < 8 * 16384; e += gthreads) {
        const int bh = e >> 14, idx = e & 16383, h = bh & 3; const float l2g = ret_log2g(h); const float g1 = exp2f(l2g), gc = exp2f(l2g * 128.f);
        float s = 0.f; const float* kv = KVC + (size_t)bh * 64 * 16384 + idx; bf16* st = SST + (size_t)bh * 64 * 16384 + idx;
#pragma unroll 8
        for (int c = 0; c < 64; ++c) { st[(size_t)c * 16384] = (bf16)f2bf(s * g1); s = s * gc + kv[(size_t)c * 16384]; }
        outRet[(size_t)bh * 16384 + idx] = s;
    }
}
__device__ __forceinline__ void ret_c_unit(const bf16* RQ, const bf16* RK, const bf16* Z, const bf16* SST, const float* gng, const float* gnb, bf16* MIX, int bh, int c, LAS unsigned char* lds, int tid, int wave, int lane) {
    const int b = bh >> 2, h = bh & 3; const size_t row0 = (size_t)b * TP + (size_t)c * 128; const float l2g = ret_log2g(h);
    LAS unsigned char* KH = lds;
    LAS unsigned char* VV = lds + 128 * RS_ROW;
    LAS unsigned char* SS = VV + 128 * RS_TR;
    LAS float* XS = (LAS float*)(SS + 128 * RS_TR);
    const bf16* sst = SST + ((size_t)bh * 64 + c) * 16384;
#pragma unroll
    for (int i = 0; i < 4; ++i) { const int cid = tid + 512 * i, j = cid >> 4, ch = cid & 15;
        const v4u kk = *(const GAS v4u*)(RK + (row0 + j) * 512 + h * 128 + ch * 8); const float sc = exp2f(-l2g * (float)j);
        v4u o; o.x = pk2(bflo(kk.x) * sc, bfhi(kk.x) * sc); o.y = pk2(bflo(kk.y) * sc, bfhi(kk.y) * sc); o.z = pk2(bflo(kk.z) * sc, bfhi(kk.z) * sc); o.w = pk2(bflo(kk.w) * sc, bfhi(kk.w) * sc);
        *(LAS v4u*)(KH + j * RS_ROW + ch * 16) = o;
        *(LAS v4u*)(VV + j * RS_TR + ch * 16) = *(const GAS v4u*)(Z + (row0 + j) * DINP + ZRV + h * 128 + ch * 8);
        *(LAS v4u*)(SS + j * RS_TR + ch * 16) = *(const GAS v4u*)(sst + j * 128 + ch * 8); }
    const int r32 = lane & 31, hi = lane >> 5, g1 = (lane >> 4) & 1, q4 = (lane & 15) >> 2, p4 = lane & 3;
    const int ib = wave >> 1, db0 = (wave & 1) * 2;
    const int iloc = ib * 32 + r32;
    bf16x8 qf[8];
#pragma unroll
    for (int s = 0; s < 8; ++s) qf[s] = *(const GAS bf16x8*)(RQ + (row0 + iloc) * 512 + h * 128 + 16 * s + 8 * hi);
    __syncthreads();
    f32x16 o0, o1;
#pragma unroll
    for (int r = 0; r < 16; ++r) { o0[r] = 0.f; o1[r] = 0.f; }
    const int laneoff = (8 * hi + q4) * RS_TR + (16 * g1 + 4 * p4) * 2;
#pragma unroll
    for (int s = 0; s < 8; ++s) {
        const LAS unsigned char* sa = SS + laneoff + s * 16 * RS_TR + db0 * 64;
        const bf16x8 s0 = join44(ldtr(sa), ldtr(sa + 4 * RS_TR));
        const bf16x8 s1 = join44(ldtr(sa + 64), ldtr(sa + 64 + 4 * RS_TR));
        o0 = __builtin_amdgcn_mfma_f32_32x32x16_bf16(s0, qf[s], o0, 0, 0, 0);
        o1 = __builtin_amdgcn_mfma_f32_32x32x16_bf16(s1, qf[s], o1, 0, 0, 0);
    }
    const int laneoffp = (4 * hi + q4) * RS_TR + (16 * g1 + 4 * p4) * 2;
    for (int jb = 0; jb <= ib; ++jb) {
        f32x16 sc;
#pragma unroll
        for (int r = 0; r < 16; ++r) sc[r] = 0.f;
#pragma unroll
        for (int s = 0; s < 8; ++s) {
            const bf16x8 kf = *(const LAS bf16x8*)(KH + (jb * 32 + r32) * RS_ROW + 32 * s + 16 * hi);
            sc = __builtin_amdgcn_mfma_f32_32x32x16_bf16(kf, qf[s], sc, 0, 0, 0);
        }
        if (jb == ib) {
#pragma unroll
            for (int r = 0; r < 16; ++r) if (crow(r, hi) > r32) sc[r] = 0.f;
        }
        const bf16x8 pb0 = pack8(sc, 0), pb1 = pack8(sc, 8);
#pragma unroll
        for (int ks = 0; ks < 2; ++ks) {
            const bf16x8 pb = ks == 0 ? pb0 : pb1;
            const LAS unsigned char* va = VV + laneoffp + (jb * 32 + ks * 16) * RS_TR + db0 * 64;
            const bf16x8 v0 = join44(ldtr(va), ldtr(va + 8 * RS_TR));
            const bf16x8 v1 = join44(ldtr(va + 64), ldtr(va + 64 + 8 * RS_TR));
            o0 = __builtin_amdgcn_mfma_f32_32x32x16_bf16(v0, pb, o0, 0, 0, 0);
            o1 = __builtin_amdgcn_mfma_f32_32x32x16_bf16(v1, pb, o1, 0, 0, 0);
        }
    }
    const float gi = exp2f(l2g * (float)iloc);
    float s1 = 0.f;
#pragma unroll
    for (int r = 0; r < 16; ++r) { o0[r] *= gi; o1[r] *= gi; s1 += o0[r] + o1[r]; }
    s1 += __shfl_xor(s1, 32);
    if (hi == 0) XS[wave * 32 + r32] = s1;
    __syncthreads();
    const float mean = (XS[wave * 32 + r32] + XS[(wave ^ 1) * 32 + r32]) * (1.f / 128.f);
    float s2 = 0.f;
#pragma unroll
    for (int r = 0; r < 16; ++r) { o0[r] -= mean; o1[r] -= mean; s2 += o0[r] * o0[r] + o1[r] * o1[r]; }
    s2 += __shfl_xor(s2, 32);
    __syncthreads();
    if (hi == 0) XS[wave * 32 + r32] = s2;
    __syncthreads();
    const float rstd = 1.0f / sqrtf((XS[wave * 32 + r32] + XS[(wave ^ 1) * 32 + r32]) * (1.f / 128.f) + LN_EPS);
    const size_t m = row0 + iloc;
    const bf16* zg = Z + m * DINP + ZRG + h * 128; bf16* orow = MIX + m * D + 512 + h * 128;
#pragma unroll
    for (int half = 0; half < 2; ++half)
#pragma unroll
        for (int g = 0; g < 4; ++g) { const int dv = (db0 + half) * 32 + 8 * g + 4 * hi;
            const f32x4 gg = *(const GAS f32x4*)(gng + h * 128 + dv), bb = *(const GAS f32x4*)(gnb + h * 128 + dv);
            const u32x2 gz = *(const GAS u32x2*)(zg + dv);
            const float gt[4] = {bflo(gz.x), bfhi(gz.x), bflo(gz.y), bfhi(gz.y)};
            float ov[4];
#pragma unroll
            for (int e = 0; e < 4; ++e) { const float x = half == 0 ? o0[4 * g + e] : o1[4 * g + e]; ov[e] = (x * rstd * gg[e] + bb[e]) * pg8::silu_f(gt[e]); }
            *(GAS u32x2*)(orow + dv) = (u32x2){pk2(ov[0], ov[1]), pk2(ov[2], ov[3])}; }
    __syncthreads();
}
constexpr int SI_STRIDE = 592;
constexpr int SI_IMG = 32 * SI_STRIDE;
constexpr int SI_Q = 4 * SI_IMG;
__device__ __forceinline__ void s_absorb_unit(const bf16* Q, const float* w_uk, bf16* QLAT, int b, LAS unsigned char* lds, int tid) {
    LAS float* qs = (LAS float*)lds;
    for (int i = tid; i < 4 * 768; i += 512) qs[i] = bf2f(Q[(size_t)(MP + b * 4) * 768 + i]);
    __syncthreads();
    const int c = tid & 255, hg = tid >> 8;
    bf16* ql = QLAT + (size_t)b * 32 * 288;
    for (int hh = 0; hh < 4; ++hh) { const int h = hg * 4 + hh; float acc[4] = {0.f, 0.f, 0.f, 0.f};
        const float* w = w_uk + (size_t)c * 512 + h * 64;
#pragma unroll 4
        for (int d = 0; d < 64; d += 4) { const f32x4 w4 = *(const GAS f32x4*)(w + d);
#pragma unroll
            for (int t = 0; t < 4; ++t) { const LAS float* q = qs + t * 768 + h * 96 + d; acc[t] += w4.x * q[0] + w4.y * q[1] + w4.z * q[2] + w4.w * q[3]; } }
#pragma unroll
        for (int t = 0; t < 4; ++t) ql[(h * 4 + t) * 288 + c] = (bf16)f2bf(acc[t]); }
    for (int i = tid; i < 1024; i += 512) { const int rho = i >> 5, e = i & 31, h = rho >> 2, t = rho & 3; ql[rho * 288 + 256 + e] = (bf16)f2bf(qs[t * 768 + h * 96 + 64 + e]); }
    __syncthreads();
}
__device__ __forceinline__ void s_attn_unit(const float* cckv, const float* ckpe, const int* ptab, const bf16* QLAT, float* PART, int b, int sp, LAS unsigned char* lds, int tid, int wave, int lane) {
    constexpr int NHP = 2 * 64 / NSPLIT;
    const int r32 = lane & 31, hi = lane >> 5, g1 = (lane >> 4) & 1, q4 = (lane & 15) >> 2, p4 = lane & 3;
    const int im = wave >> 2, qt = wave & 3;
    for (int i = tid; i < 32 * 36; i += 512) { const int row = i / 36, ch = i % 36; *(LAS v4u*)(lds + SI_Q + row * SI_STRIDE + ch * 16) = *(const GAS v4u*)(QLAT + (size_t)b * 32 * 288 + row * 288 + ch * 8); }
    f32x4 R[9];
    const int* pt = ptab + b * 64 + sp * (64 / NSPLIT);
    const int st_c = wave * SI_STRIDE + (tid & 63) * 8, st_k = (tid >> 3) * SI_STRIDE + 512 + (tid & 7) * 8 + ((tid >> 8) ? SI_IMG - 32 * SI_STRIDE : 0);
#define SA_LOAD(hp) do { const size_t pid_ = (size_t)pt[(hp) >> 1]; const float* cp_ = cckv + pid_ * 32768 + ((hp) & 1) * 16384; const float* kp_ = ckpe + pid_ * 4096 + ((hp) & 1) * 2048; \
        _Pragma("unroll") for (int i_ = 0; i_ < 8; ++i_) R[i_] = *(const GAS f32x4*)(cp_ + (size_t)(i_ * 512 + tid) * 4); \
        R[8] = *(const GAS f32x4*)(kp_ + (size_t)tid * 4); } while (0)
#define SA_STORE(buf) do { LAS unsigned char* ib_ = lds + (buf) * 2 * SI_IMG; \
        _Pragma("unroll") for (int i_ = 0; i_ < 8; ++i_) *(LAS u32x2*)(ib_ + (i_ >> 2) * SI_IMG + (i_ & 3) * 8 * SI_STRIDE + st_c) = (u32x2){pk2(R[i_].x, R[i_].y), pk2(R[i_].z, R[i_].w)}; \
        *(LAS u32x2*)(ib_ + st_k) = (u32x2){pk2(R[8].x, R[8].y), pk2(R[8].z, R[8].w)}; } while (0)
    float m_run = -INFINITY, l_run = 0.f; f32x16 oa[2];
#pragma unroll
    for (int cb = 0; cb < 2; ++cb)
#pragma unroll
        for (int r = 0; r < 16; ++r) oa[cb][r] = 0.f;
    SA_LOAD(0); SA_STORE(0); SA_LOAD(1);
    __syncthreads();
    const LAS unsigned char* qi = lds + SI_Q;
    for (int hp = 0; hp < NHP; ++hp) {
        const LAS unsigned char* img = lds + ((hp & 1) * 2 + im) * SI_IMG;
        f32x16 st;
#pragma unroll
        for (int r = 0; r < 16; ++r) st[r] = 0.f;
#pragma unroll 6
        for (int s = 0; s < 18; ++s) {
            const bf16x8 a = *(const LAS bf16x8*)(img + r32 * SI_STRIDE + 32 * s + 16 * hi);
            const bf16x8 q = *(const LAS bf16x8*)(qi + r32 * SI_STRIDE + 32 * s + 16 * hi);
            st = __builtin_amdgcn_mfma_f32_32x32x16_bf16(a, q, st, 0, 0, 0);
        }
        float mx = st[0];
#pragma unroll
        for (int r = 1; r < 16; ++r) mx = fmaxf(mx, st[r]);
        mx = fmaxf(mx, __shfl_xor(mx, 32));
        const float m_new = fmaxf(m_run, mx); const float alpha = __builtin_amdgcn_exp2f(m_run - m_new); m_run = m_new;
        float ps = 0.f;
#pragma unroll
        for (int r = 0; r < 16; ++r) { st[r] = __builtin_amdgcn_exp2f(st[r] - m_new); ps += st[r]; }
        l_run = l_run * alpha + ps;
        const bf16x8 pb0 = pack8(st, 0), pb1 = pack8(st, 8);
#pragma unroll
        for (int cb = 0; cb < 2; ++cb) {
#pragma unroll
            for (int r = 0; r < 16; ++r) oa[cb][r] *= alpha;
            const int c0 = (2 * qt + cb) * 32;
#pragma unroll
            for (int ks = 0; ks < 2; ++ks) {
                const LAS unsigned char* va = img + (16 * ks + 4 * hi + q4) * SI_STRIDE + (c0 + 16 * g1 + 4 * p4) * 2;
                const bf16x8 vf = join44(ldtr(va), ldtr(va + 8 * SI_STRIDE));
                oa[cb] = __builtin_amdgcn_mfma_f32_32x32x16_bf16(vf, ks == 0 ? pb0 : pb1, oa[cb], 0, 0, 0);
            }
        }
        if (hp + 1 < NHP) SA_STORE((hp + 1) & 1);
        if (hp + 2 < NHP) SA_LOAD(hp + 2);
        __syncthreads();
    }
#undef SA_LOAD
#undef SA_STORE
    float* rec = PART + ((size_t)(b * NSPLIT + sp) * 2 + im) * PART_F;
    const float lt = l_run + __shfl_xor(l_run, 32);
    if (qt == 0 && hi == 0) { rec[r32] = m_run; rec[32 + r32] = lt; }
#pragma unroll
    for (int cb = 0; cb < 2; ++cb)
#pragma unroll
        for (int r = 0; r < 16; ++r) rec[64 + ((2 * qt + cb) * 32 + crow(r, hi)) * 32 + r32] = oa[cb][r];
}
__device__ __forceinline__ void s_combine_unit(const float* PART, const bf16* QLAT, const bf16* CKVN, const bf16* KPEB, const bf16* WUVT, bf16* MIX, int b, LAS unsigned char* lds, int tid, int wave, int lane) {
    constexpr int NP = 2 * NSPLIT; constexpr int OS = 528;
    LAS unsigned char* OLB = lds;
    LAS float* WP = (LAS float*)(lds + 32 * OS);
    LAS float* EJ = WP + NP * 32;
    LAS float* SN = EJ + 4 * 32;
    LAS float* KNW = SN + 32 * 4;
    const size_t mrow = (size_t)MP + (size_t)b * 4;
    for (int i = tid; i < 4 * 288; i += 512) { const int j = i / 288, c = i % 288; KNW[i] = c < 256 ? bf2f(CKVN[(mrow + j) * 256 + c]) : bf2f(KPEB[(mrow + j) * 32 + (c - 256)]); }
    __syncthreads();
    { const int q = tid >> 4, part = tid & 15; const bf16* ql = QLAT + (size_t)b * 32 * 288 + q * 288 + part * 18; float s[4] = {0.f, 0.f, 0.f, 0.f};
      for (int e = 0; e < 18; ++e) { const float qv = bf2f(ql[e]);
#pragma unroll
          for (int j = 0; j < 4; ++j) s[j] += qv * KNW[j * 288 + part * 18 + e]; }
#pragma unroll
      for (int j = 0; j < 4; ++j) { s[j] += __shfl_xor(s[j], 1); s[j] += __shfl_xor(s[j], 2); s[j] += __shfl_xor(s[j], 4); s[j] += __shfl_xor(s[j], 8); }
      if (part == 0) {
#pragma unroll
          for (int j = 0; j < 4; ++j) SN[q * 4 + j] = s[j]; } }
    __syncthreads();
    const float* rec0 = PART + (size_t)b * NP * PART_F;
    if (tid < 32) { const int q = tid, t = q & 3; float mg = -INFINITY; float mp[NP];
#pragma unroll
        for (int p = 0; p < NP; ++p) { mp[p] = rec0[(size_t)p * PART_F + q]; mg = fmaxf(mg, mp[p]); }
        for (int j = 0; j <= t; ++j) mg = fmaxf(mg, SN[q * 4 + j]);
        float L = 0.f; float wp[NP], ej[4];
#pragma unroll
        for (int p = 0; p < NP; ++p) { wp[p] = exp2f(mp[p] - mg); L += wp[p] * rec0[(size_t)p * PART_F + 32 + q]; }
#pragma unroll
        for (int j = 0; j < 4; ++j) { ej[j] = (j <= t) ? exp2f(SN[q * 4 + j] - mg) : 0.f; L += ej[j]; }
        const float iL = 1.0f / L;
#pragma unroll
        for (int p = 0; p < NP; ++p) WP[p * 32 + q] = wp[p] * iL;
#pragma unroll
        for (int j = 0; j < 4; ++j) EJ[j * 32 + q] = ej[j] * iL; }
    __syncthreads();
    { const int q = tid & 31, cg = tid >> 5; float wq[NP], eq[4];
#pragma unroll
      for (int p = 0; p < NP; ++p) wq[p] = WP[p * 32 + q];
#pragma unroll
      for (int j = 0; j < 4; ++j) eq[j] = EJ[j * 32 + q];
#pragma unroll 4
      for (int ci = 0; ci < 16; ++ci) { const int c = cg * 16 + ci; float acc = 0.f;
#pragma unroll
          for (int p = 0; p < NP; ++p) acc += wq[p] * rec0[(size_t)p * PART_F + 64 + c * 32 + q];
#pragma unroll
          for (int j = 0; j < 4; ++j) acc += eq[j] * KNW[j * 288 + c];
          *(LAS bf16*)(OLB + q * OS + c * 2) = (bf16)f2bf(acc); } }
    __syncthreads();
    { const int r32 = lane & 31, hi = lane >> 5, h = wave; f32x16 a0, a1;
#pragma unroll
      for (int r = 0; r < 16; ++r) { a0[r] = 0.f; a1[r] = 0.f; }
      const bf16* wb = WUVT + (size_t)(h * 64 + r32) * 256 + 8 * hi;
#pragma unroll
      for (int ks = 0; ks < 16; ++ks) {
          const bf16x8 af = *(const LAS bf16x8*)(OLB + r32 * OS + 32 * ks + 16 * hi);
          const bf16x8 b0 = *(const GAS bf16x8*)(wb + 16 * ks), b1 = *(const GAS bf16x8*)(wb + 32 * 256 + 16 * ks);
          a0 = __builtin_amdgcn_mfma_f32_32x32x16_bf16(af, b0, a0, 0, 0, 0);
          a1 = __builtin_amdgcn_mfma_f32_32x32x16_bf16(af, b1, a1, 0, 0, 0);
      }
      const int g = h >> 1; float v0[4], v1[4];
#pragma unroll
      for (int t = 0; t < 4; ++t) { v0[t] = g == 0 ? a0[t] : g == 1 ? a0[4 + t] : g == 2 ? a0[8 + t] : a0[12 + t]; v1[t] = g == 0 ? a1[t] : g == 1 ? a1[4 + t] : g == 2 ? a1[8 + t] : a1[12 + t]; }
      if (hi == (h & 1)) {
#pragma unroll
          for (int t = 0; t < 4; ++t) { bf16* o = MIX + (mrow + t) * D + h * 64 + r32; o[0] = (bf16)f2bf(v0[t]); o[32] = (bf16)f2bf(v1[t]); } } }
    __syncthreads();
}
__device__ __forceinline__ void s_ret_unit(const bf16* RQ, const bf16* RK, const bf16* Z, const float* state0, const float* gng, const float* gnb, float* outRet, bf16* MIX, int b, int h, LAS unsigned char* lds, int tid, int wave, int lane) {
    LAS float* qv = (LAS float*)lds; LAS float* kv = qv + 512; LAS float* vv = kv + 512; LAS float* red = vv + 512;
    LAS float* qk = red + 2048; LAS float* ro = qk + 16; LAS float* prt = ro + 512;
    const size_t mrow = (size_t)MP + (size_t)b * 4; const float l2g = ret_log2g(h);
    { const int j = tid >> 7, d = tid & 127; qv[tid] = bf2f(RQ[(mrow + j) * 512 + h * 128 + d]); kv[tid] = bf2f(RK[(mrow + j) * 512 + h * 128 + d]); vv[tid] = bf2f(Z[(mrow + j) * DINP + ZRV + h * 128 + d]); }
    __syncthreads();
    if (tid < 16) { const int i = tid >> 2, j = tid & 3; float s = 0.f; for (int d = 0; d < 128; ++d) s += qv[i * 128 + d] * kv[j * 128 + d]; qk[tid] = s; }
    const int dv = tid & 127, qd = tid >> 7;
    const float* S0 = state0 + (size_t)(b * 4 + h) * 16384; float* S1 = outRet + (size_t)(b * 4 + h) * 16384;
    const float g4 = exp2f(l2g * 4.f), g3 = exp2f(l2g * 3.f), g2 = exp2f(l2g * 2.f), g1v = exp2f(l2g);
    const float v0 = vv[dv] * g3, v1 = vv[128 + dv] * g2, v2 = vv[256 + dv] * g1v, v3 = vv[384 + dv];
    float oacc[4] = {0.f, 0.f, 0.f, 0.f};
#pragma unroll 4
    for (int dk = qd * 32; dk < qd * 32 + 32; ++dk) { const float s0 = S0[dk * 128 + dv];
#pragma unroll
        for (int i = 0; i < 4; ++i) oacc[i] += qv[i * 128 + dk] * s0;
        S1[dk * 128 + dv] = g4 * s0 + kv[dk] * v0 + kv[128 + dk] * v1 + kv[256 + dk] * v2 + kv[384 + dk] * v3; }
#pragma unroll
    for (int i = 0; i < 4; ++i) red[(qd * 4 + i) * 128 + dv] = oacc[i];
    __syncthreads();
    { const int i = tid >> 7; float o = (red[(0 * 4 + i) * 128 + dv] + red[(1 * 4 + i) * 128 + dv]) + (red[(2 * 4 + i) * 128 + dv] + red[(3 * 4 + i) * 128 + dv]);
      o *= exp2f(l2g * (float)(i + 1));
      for (int j = 0; j <= i; ++j) o += exp2f(l2g * (float)(i - j)) * qk[i * 4 + j] * vv[j * 128 + dv];
      const float s = wave_sum(o); if (lane == 0) prt[wave] = s;
      __syncthreads();
      const float mean = (prt[2 * i] + prt[2 * i + 1]) * (1.f / 128.f); const float dd = o - mean;
      __syncthreads();
      const float s2 = wave_sum(dd * dd); if (lane == 0) prt[wave] = s2;
      __syncthreads();
      const float rstd = 1.0f / sqrtf((prt[2 * i] + prt[2 * i + 1]) * (1.f / 128.f) + LN_EPS);
      const float gate = bf2f(Z[(mrow + i) * DINP + ZRG + h * 128 + dv]);
      MIX[(mrow + i) * D + 512 + h * 128 + dv] = (bf16)f2bf((dd * rstd * gng[h * 128 + dv] + gnb[h * 128 + dv]) * pg8::silu_f(gate)); }
    __syncthreads();
}
template <int J> __device__ __forceinline__ void pool_group8(const Args& A, const float* XF, bf16* POOLA, int m0, int t0, int lane) {
    constexpr int W = 2 << J, NR = W + 7;
    f32x4 xr[NR];
#pragma unroll
    for (int i = 0; i < NR; ++i) { const int dt = i - (W - 1); xr[i] = (t0 + dt >= 0) ? ((const GAS f32x4*)(XF + (size_t)(m0 + dt) * D) + lane)[64 * J] : (f32x4){0.f, 0.f, 0.f, 0.f}; }
    f32x4 s = xr[0];
#pragma unroll
    for (int i = 1; i < W; ++i) s = s + xr[i];
#pragma unroll
    for (int r = 0; r < 8; ++r) { const int t = t0 + r; const float cnt = (float)((t + 1 < W) ? t + 1 : W);
        const f32x4 hv = xr[r + W - 1]; const f32x4 o = s / cnt - hv;
        *(GAS unsigned long long*)(POOLA + ((size_t)J * MT + m0 + r) * 256 + 4 * lane) = (unsigned long long)pk2(o.x, o.y) | ((unsigned long long)pk2(o.z, o.w) << 32);
        if (t >= TP - 15) ((GAS f32x4*)(A.out + OUT_POOLP + ((size_t)((m0 + r) >> 13) * 15 + (t - (TP - 15))) * D) + lane)[64 * J] = hv;
        if (r < 7) s = s + xr[r + W] - xr[r]; }
}
__device__ __forceinline__ void pool_prep(const Args& A, const float* XF, bf16* POOLA, int gw, int NGW, int lane) {
    const float* spool = A.in[5];
    for (int blk = gw; blk < MP / 8; blk += NGW) { const int m0 = blk * 8, t0 = m0 & 8191;
        pool_group8<0>(A, XF, POOLA, m0, t0, lane); pool_group8<1>(A, XF, POOLA, m0, t0, lane); pool_group8<2>(A, XF, POOLA, m0, t0, lane); pool_group8<3>(A, XF, POOLA, m0, t0, lane); }
    for (int m = MP + (NGW - 1 - gw); m < MT; m += NGW) {
        const int t = (m - MP) & 3; const int bs = (m - MP) >> 2;
        const GAS f32x4* hrow = (const GAS f32x4*)(XF + (size_t)m * D) + lane;
        f32x4 hv[4];
#pragma unroll
        for (int j = 0; j < 4; ++j) hv[j] = hrow[64 * j];
#pragma unroll
        for (int j = 0; j < 4; ++j) { const int wl = 2 << j; f32x4 s = hv[j];
            for (int k = 1; k < wl; ++k) { const int tt = t - k;
                if (tt >= 0) s = s + ((const GAS f32x4*)(XF + (size_t)(m - k) * D) + lane)[64 * j];
                else s = s + ((const GAS f32x4*)(spool + ((size_t)bs * 15 + 15 + tt) * D) + lane)[64 * j]; }
            const f32x4 o = s / (float)wl - hv[j];
            *(GAS unsigned long long*)(POOLA + ((size_t)j * MT + m) * 256 + 4 * lane) = (unsigned long long)pk2(o.x, o.y) | ((unsigned long long)pk2(o.z, o.w) << 32); }
        { GAS f32x4* o = (GAS f32x4*)(A.out + OUT_POOLS + ((size_t)bs * 15 + 11 + t) * D) + lane;
#pragma unroll
            for (int j = 0; j < 4; ++j) o[64 * j] = hv[j];
            if (t == 0) for (int i = 0; i < 11; ++i) { const GAS f32x4* src = (const GAS f32x4*)(spool + ((size_t)bs * 15 + i + 4) * D) + lane; GAS f32x4* dst = (GAS f32x4*)(A.out + OUT_POOLS + ((size_t)bs * 15 + i) * D) + lane;
#pragma unroll
                for (int j = 0; j < 4; ++j) dst[64 * j] = src[64 * j]; } }
    }
}
struct PoolOrder {
    int G, c;
    __device__ __forceinline__ bool next(int i, pg8::Unit& u) const { const long L = (long)i * G + c; if (L >= 4 * (MT / 256)) return false; const int g = (int)L / (MT / 256), pm = (int)L % (MT / 256); u.pm = g * (MT / 256) + pm; u.pn = g; return true; }
    __device__ __forceinline__ void a_ready(const pg8::Unit&) const {}
    __device__ __forceinline__ void done(const pg8::Unit&) const {}
};
struct EpiPoolF32 {
    static constexpr bool PERM = false, AFTER_DRAIN = false;
    float* C;
    __device__ __forceinline__ void operator()(const pg8::f32x4 (&acc)[2][2][4][2], const pg8::Unit& u, int wr, int wc, int fr, int fq) const {
        const int row0 = (u.pm % (MT / 256)) * 256 + wr * 64 + fr, col0 = u.pn * 256 + wc * 32 + 4 * fq;
#pragma unroll
        for (int ai = 0; ai < 2; ++ai)
#pragma unroll
            for (int m = 0; m < 4; ++m) { float* rowp = C + (size_t)(row0 + ai * 128 + m * 16) * D + col0;
#pragma unroll
                for (int bj = 0; bj < 2; ++bj)
#pragma unroll
                    for (int n = 0; n < 2; ++n) *(pg8::f32x4*)(rowp + bj * 128 + n * 16) = acc[ai][bj][m][n]; }
    }
};


#ifndef MK_PER_PHASE
#define MK_PER_PHASE 0
#endif
constexpr int N_STEPS = 24;
#ifndef MK_STEPS_RUN
#define MK_STEPS_RUN 24
#endif
#ifndef MK_DIAG_PAGE
#define MK_DIAG_PAGE -1
#endif
#ifndef MK_SKIP
#define MK_SKIP 0
#endif
#define MK_ON(k) (((MK_SKIP >> (k)) & 1) == 0)
__global__ void __launch_bounds__(NWAVES * 64, 2) mk_fwd(Args args) {
    extern __shared__ __attribute__((aligned(16))) unsigned char lds_raw[];
    LAS unsigned char* lds = (LAS unsigned char*)lds_raw;
    volatile LAS unsigned* MISC = (volatile LAS unsigned*)(lds + MISC_OFF);
    const int G = gridDim.x, bx = blockIdx.x;
    const int vcu = (G % 8 == 0) ? (bx % 8) * (G / 8) + bx / 8 : bx;
    const int NGW = G * NWAVES;
    unsigned char* ws = args.ws;
    gu32* ctl = (gu32*)(ws + WS_CTL);
    for (int u = threadIdx.x; u < (LDS_BYTES - LDSCTL_OFF) / 4; u += NWAVES * 64) ((LAS unsigned*)(lds + LDSCTL_OFF))[u] = 0u;
    __syncthreads();
    XcdBarrier bar; bar.bar = (unsigned*)(ctl + CW_BAR); bar.x = 0; bar.st = nullptr;
    if (!MK_PER_PHASE) bar = xcd_barrier_post((unsigned*)(ctl + CW_BAR), MISC + 8);
    const int lo = args.ph_lo, hi = args.ph_hi;
    int step = 0;
    if (MK_DIAG_PAGE >= 0 && blockIdx.x == 0 && threadIdx.x == 0) { const size_t oo[10] = {OUT_YP, OUT_YS, OUT_CKVP, OUT_KPEP, OUT_CKVS, OUT_KPES, OUT_RETP, OUT_RETS, OUT_POOLP, OUT_POOLS};
#pragma unroll
        for (int k = 0; k < 10; ++k) ((float*)(ws + 65536 + 1024))[k] = args.out[oo[k]];
        ((unsigned long long*)(ws + 65536))[0] = rt(); }
#define STEP_IF if (lo <= step && step < hi)
#define FRESH_TID int tid_f = threadIdx.x; asm volatile("" : "+v"(tid_f)); const int tid = tid_f, lane = tid & 63, wave = __builtin_amdgcn_readfirstlane(tid >> 6), gw = vcu * NWAVES + wave; (void)lane; (void)gw
#define STEP_END do { if (lo <= step && step + 1 < hi) { xcd_barrier(bar); } ++step; if (MK_DIAG_PAGE >= 0 && blockIdx.x == 0 && threadIdx.x == 0) ((unsigned long long*)(ws + 65536))[step] = rt(); } while (0)

    bf16* XB = (bf16*)(ws + WS_XB); float* XF = (float*)(ws + WS_XF); float* Y = (float*)(ws + WS_Y); bf16* HFF = (bf16*)(ws + WS_HFF);
    bf16* Z = (bf16*)(ws + WS_Z); bf16* MIX = (bf16*)(ws + WS_MIX);
    const float* ln_gain = args.in[10]; const float* ln_bias = args.in[11];

    STEP_IF if (MK_ON(0)) { FRESH_TID; p0_prologue(args, lds, gw, NGW, wave, lane); }
    STEP_END;

#pragma unroll
    for (int f = 0; f < 4; ++f) {
        const int layer = f >> 1, mm = f & 1;
        STEP_IF if (MK_ON(1)) { FRESH_TID; pg8::Gemm g{XB, (const bf16*)(ws + WS_WGU) + (size_t)f * NGU * D, MT, NGU, D}; pg8::StaticOrder S; S.init(MT, NGU, G, bx);
            pg8::EpiSwiGLU E{HFF, DFF};
            pg8::gemm_phase<pg8::EpiSwiGLU, pg8::StaticOrder, true, true>(lds + RING_OFF, g, S, E); }
        STEP_END;
        STEP_IF if (MK_ON(2)) { FRESH_TID; pg8::Gemm g{HFF, (const bf16*)(ws + WS_WD) + (size_t)f * D * DFF, MT, D, DFF}; pg8::StaticOrder S; S.init(MT, D, G, bx);
            pg8::EpiF32 E{Y, D};
            pg8::gemm_phase<pg8::EpiF32, pg8::StaticOrder, true, true>(lds + RING_OFF, g, S, E); }
        STEP_END;
        STEP_IF if (MK_ON(3)) { FRESH_TID; ln_phase(args, f == 0 ? nullptr : XF, Y, 0.5f, nullptr, nullptr, ln_gain + (layer * 3 + 2 * mm) * D, ln_bias + (layer * 3 + 2 * mm) * D, f == 3 ? args.out : XF, XB, gw, NGW, lane); }
        STEP_END;

        if (f == 0) {
            STEP_IF if (MK_ON(4)) { FRESH_TID; pg8::Gemm g{XB, (const bf16*)(ws + WS_WIN), MT, DINP, D}; pg8::StaticOrder S; S.init(MT, DINP, G, bx);
                pg8::EpiBf16P E{Z, DINP};
                pg8::gemm_phase<pg8::EpiBf16P, pg8::StaticOrder, true, true>(lds + RING_OFF, g, S, E); }
            STEP_END;
            STEP_IF if (MK_ON(5)) { FRESH_TID; post_phase(args, gw, NGW, lane); }
            STEP_END;
            STEP_IF if (MK_ON(6)) { FRESH_TID;
                { pg8::Gemm g{(const bf16*)(ws + WS_QLN), (const bf16*)(ws + WS_WUQ), MT, 768, 512}; pg8::StaticOrder S; S.init(MT, 768, G, bx);
                  pg8::EpiQ E{(bf16*)(ws + WS_Q), (const float2*)(ws + WS_ROPE32), QSCALE};
                  pg8::gemm_phase<pg8::EpiQ, pg8::StaticOrder, true, true>(lds + RING_OFF, g, S, E); }
                __syncthreads();
                { pg8::Gemm g{(const bf16*)(ws + WS_CKVN), (const bf16*)(ws + WS_WUKT), MP, 512, 256}; pg8::StaticOrder S; S.init(MP, 512, G, (bx + G - 198 % G) % G);
                  pg8::EpiBf16P E{(bf16*)(ws + WS_KN), 512};
                  pg8::gemm_phase<pg8::EpiBf16P, pg8::StaticOrder, true, true>(lds + RING_OFF, g, S, E); }
                __syncthreads();
                { pg8::Gemm g{(const bf16*)(ws + WS_WUVT), (const bf16*)(ws + WS_CKVN), 512, MP, 256}; pg8::StaticOrder S; S.init(512, MP, G, (bx + G - 70 % G) % G);
                  pg8::EpiBf16P E{(bf16*)(ws + WS_VT), MP};
                  pg8::gemm_phase<pg8::EpiBf16P, pg8::StaticOrder, true, true>(lds + RING_OFF, g, S, E); }
                __syncthreads();
                for (int u = vcu; u < 512; u += G) ret_a_unit((const bf16*)(ws + WS_RK), Z, (float*)(ws + WS_KVC), u >> 6, u & 63, lds, tid, wave, lane);
            }
            STEP_END;
            STEP_IF if (MK_ON(7)) { FRESH_TID;
                ret_scan((const float*)(ws + WS_KVC), (bf16*)(ws + WS_SST), args.out + OUT_RETP, vcu * 512 + tid, G * 512);
                for (int u = vcu; u < NBS; u += G) s_absorb_unit((const bf16*)(ws + WS_Q), args.in[16], (bf16*)(ws + WS_QLAT), u, lds, tid);
                for (int u = vcu; u < 256; u += G) { const int bh = u >> 4, s = u & 15;
                    attn_unit_prompt((const bf16*)(ws + WS_Q), (const bf16*)(ws + WS_KN), (const bf16*)(ws + WS_KPEB), (const bf16*)(ws + WS_VT), MIX, bh >> 3, bh & 7, s, lds, tid, wave, lane);
                    attn_unit_prompt((const bf16*)(ws + WS_Q), (const bf16*)(ws + WS_KN), (const bf16*)(ws + WS_KPEB), (const bf16*)(ws + WS_VT), MIX, bh >> 3, bh & 7, 31 - s, lds, tid, wave, lane); }
            }
            STEP_END;
            STEP_IF if (MK_ON(8)) { FRESH_TID;
                for (int u = vcu; u < NBS * NSPLIT; u += G) s_attn_unit(args.in[2], args.in[3], (const int*)args.in[6], (const bf16*)(ws + WS_QLAT), (float*)(ws + WS_PART), u / NSPLIT, u % NSPLIT, lds, tid, wave, lane);
                __syncthreads();
                for (int u = vcu; u < 512; u += G) ret_c_unit((const bf16*)(ws + WS_RQ), (const bf16*)(ws + WS_RK), Z, (const bf16*)(ws + WS_SST), args.in[18], args.in[19], MIX, u >> 6, u & 63, lds, tid, wave, lane);
                for (int u = vcu; u < NBS * 4; u += G) s_ret_unit((const bf16*)(ws + WS_RQ), (const bf16*)(ws + WS_RK), Z, args.in[4], args.in[18], args.in[19], args.out + OUT_RETS, MIX, u >> 2, u & 3, lds, tid, wave, lane);
            }
            STEP_END;
            STEP_IF if (MK_ON(9)) { FRESH_TID; for (int u = vcu; u < NBS; u += G) s_combine_unit((const float*)(ws + WS_PART), (const bf16*)(ws + WS_QLAT), (const bf16*)(ws + WS_CKVN), (const bf16*)(ws + WS_KPEB), (const bf16*)(ws + WS_WUVT), MIX, u, lds, tid, wave, lane); }
            STEP_END;
            STEP_IF if (MK_ON(10)) { FRESH_TID; pg8::Gemm g{MIX, (const bf16*)(ws + WS_WOUT), MT, D, D}; pg8::StaticOrder S; S.init(MT, D, G, bx);
                pg8::EpiF32 E{Y, D};
                pg8::gemm_phase<pg8::EpiF32, pg8::StaticOrder, true, true>(lds + RING_OFF, g, S, E); }
            STEP_END;
            STEP_IF if (MK_ON(11)) { FRESH_TID; ln_phase(args, XF, Y, 1.0f, nullptr, nullptr, ln_gain + (0 * 3 + 1) * D, ln_bias + (0 * 3 + 1) * D, XF, XB, gw, NGW, lane); }
            STEP_END;
        }
        if (f == 2) {
            STEP_IF if (MK_ON(12)) { FRESH_TID; pool_prep(args, XF, (bf16*)(ws + WS_POOLA), gw, NGW, lane); }
            STEP_END;
            STEP_IF if (MK_ON(13)) { FRESH_TID; pg8::Gemm g{(const bf16*)(ws + WS_POOLA), (const bf16*)(ws + WS_WPOOL), 4 * MT, D, 256}; PoolOrder S{G, bx};
                EpiPoolF32 E{Y};
                pg8::gemm_phase<EpiPoolF32, PoolOrder, true, true>(lds + RING_OFF, g, S, E); }
            STEP_END;
            STEP_IF if (MK_ON(14)) { FRESH_TID; ln_phase(args, XF, Y, 1.0f, args.in[22], args.in[23], ln_gain + (1 * 3 + 1) * D, ln_bias + (1 * 3 + 1) * D, XF, XB, gw, NGW, lane); }
            STEP_END;
        }
    }
    if (MK_DIAG_PAGE >= 0) { xcd_barrier(bar);
        if (blockIdx.x == 0) { const size_t oo[10] = {OUT_YP, OUT_YS, OUT_CKVP, OUT_KPEP, OUT_CKVS, OUT_KPES, OUT_RETP, OUT_RETS, OUT_POOLP, OUT_POOLS};
            const unsigned long long* st = (const unsigned long long*)(ws + 65536); const float* fv = (const float*)(ws + 65536 + 1024);
#pragma unroll
            for (int k = 0; k < 10; ++k) { const int si = MK_DIAG_PAGE * 10 + k; int n = 0;
                if (si < N_STEPS) n = (int)((__hip_atomic_load(st + si + 1, __ATOMIC_RELAXED, __HIP_MEMORY_SCOPE_AGENT) - __hip_atomic_load(st + si, __ATOMIC_RELAXED, __HIP_MEMORY_SCOPE_AGENT)) / 100ull) + 1;
                else if (si == N_STEPS) n = (int)((__hip_atomic_load(st + N_STEPS, __ATOMIC_RELAXED, __HIP_MEMORY_SCOPE_AGENT) - __hip_atomic_load(st, __ATOMIC_RELAXED, __HIP_MEMORY_SCOPE_AGENT)) / 100ull) + 1;
                const float f = fv[k]; for (int e = threadIdx.x; e < n; e += NWAVES * 64) args.out[oo[k] + e] = f; } } }
#undef STEP_IF
#undef STEP_END
}


#ifdef MK_SANITIZE
__global__ void __launch_bounds__(256) mk_sanitize(float* out, size_t n) {
    for (size_t i = (size_t)blockIdx.x * 256 + threadIdx.x; i < n; i += (size_t)gridDim.x * 256) { const float v = out[i]; if (!(fabsf(v) < 3.0e38f)) out[i] = 0.f; }
}
#endif
extern "C" void kernel_launch(void* const* d_in, const int* in_sizes, int n_in, void* d_out, int out_size, void* d_ws, size_t ws_size, hipStream_t stream) {
    static int grid = 0;
    if (grid == 0) {
        if (n_in != 24 || (size_t)out_size != OUT_TOTAL || ws_size < WS_END) { fprintf(stderr, "kernel_launch: unexpected shapes: n_in %d out %d ws %zu\n", n_in, out_size, ws_size); grid = -1; return; }
        int dev = 0, cus = 0, per_cu = 0;
        if (hipGetDevice(&dev) != hipSuccess || hipDeviceGetAttribute(&cus, hipDeviceAttributeMultiprocessorCount, dev) != hipSuccess) { grid = -1; return; }
        if (hipFuncSetAttribute((const void*)mk_fwd, hipFuncAttributeMaxDynamicSharedMemorySize, LDS_BYTES) != hipSuccess) { fprintf(stderr, "kernel_launch: hipFuncSetAttribute failed\n"); grid = -1; return; }
        if (hipOccupancyMaxActiveBlocksPerMultiprocessor(&per_cu, (const void*)mk_fwd, NWAVES * 64, LDS_BYTES) != hipSuccess || per_cu < 1)
            fprintf(stderr, "kernel_launch: note: occupancy query reports %d workgroups per CU\n", per_cu);
        (void)hipGetLastError();
        grid = cus;
    }
    if (grid < 0) return;
    if (hipMemsetAsync((char*)d_ws + WS_CTL, 0, CTL_ZERO_BYTES, stream) != hipSuccess) return;
#if MK_STEPS_RUN < N_STEPS
    (void)hipMemsetAsync(d_out, 0, (size_t)out_size * 4, stream);
#endif
    Args a{};
    for (int i = 0; i < 24; ++i) a.in[i] = (const float*)d_in[i];
    a.out = (float*)d_out; a.ws = (unsigned char*)d_ws;
#if MK_PER_PHASE
    for (int s = 0; s < MK_STEPS_RUN; ++s) { a.ph_lo = s; a.ph_hi = s + 1; hipLaunchKernelGGL(mk_fwd, dim3(grid), dim3(NWAVES * 64), LDS_BYTES, stream, a); }
#else
    a.ph_lo = 0; a.ph_hi = N_STEPS;
    hipLaunchKernelGGL(mk_fwd, dim3(grid), dim3(NWAVES * 64), LDS_BYTES, stream, a);
#endif
#ifdef MK_SANITIZE
    hipLaunchKernelGGL(mk_sanitize, dim3(2048), dim3(256), 0, stream, (float*)d_out, (size_t)out_size);
#endif
    const hipError_t le = hipPeekAtLastError();
    if (le != hipSuccess) fprintf(stderr, "kernel_launch: launch failed: %s\n", hipGetErrorName(le));
}
```
